# Optimizing an MI355X kernel written in HIP

```python
import jax, jax.numpy as jnp
from jax import lax
import numpy as np

D_MODEL = 1024
BATCH = 8
SEQ = 2048
DEPTH = 1

HEAD_DIM = 64
N_FOX_HEADS = 8
DIL_GROUPS = ((128, 1), (512, 4), (2048, 16))
N_DIL_HEADS_PER_GROUP = 4
N_DIL_HEADS = N_DIL_HEADS_PER_GROUP * len(DIL_GROUPS)
FOX_W = N_FOX_HEADS * HEAD_DIM
DIL_W = N_DIL_HEADS * HEAD_DIM
DIL_OUT_W = N_DIL_HEADS_PER_GROUP * HEAD_DIM
ROT_DIM = HEAD_DIM // 4
ROPE_THETA = 500000.0
D_FF = -(-8 * D_MODEL // (3 * 256)) * 256
Q_BLOCK = 128
EPS = 1e-6
NEG = -1e30
SPLIT_SIZES = (FOX_W, FOX_W, FOX_W, N_FOX_HEADS, DIL_W, DIL_W, DIL_W, D_MODEL, D_MODEL)
IN_COLS = sum(SPLIT_SIZES)

kernel_name = "hybrid_fox_dilated_adaln_block"


def rmsnorm(x, g):
    xf = x.astype(jnp.float32)
    y = xf * lax.rsqrt(jnp.mean(xf * xf, axis=-1, keepdims=True) + EPS)
    return (y * g.astype(jnp.float32)).astype(x.dtype)


def modulate(h, shift, scale):
    return h * (1 + scale[:, None, :]) + shift[:, None, :]


def partial_rope(t):
    S = t.shape[1]
    pos = jnp.arange(S, dtype=jnp.float32)
    inv_freq = ROPE_THETA ** (-jnp.arange(0, ROT_DIM, 2, dtype=jnp.float32) / ROT_DIM)
    ang = pos[:, None] * inv_freq[None, :]
    cos = jnp.cos(ang)[None, :, None, :]
    sin = jnp.sin(ang)[None, :, None, :]
    tf = t.astype(jnp.float32)
    x1 = tf[..., : ROT_DIM // 2]
    x2 = tf[..., ROT_DIM // 2: ROT_DIM]
    rot = jnp.concatenate([x1 * cos - x2 * sin, x2 * cos + x1 * sin], axis=-1)
    return jnp.concatenate([rot, tf[..., ROT_DIM:]], axis=-1).astype(t.dtype)


def forgetting_attention(q, k, v, f_logit):
    B, S, H, Dh = q.shape
    scale = Dh ** -0.5
    F = jnp.cumsum(jax.nn.log_sigmoid(f_logit.astype(jnp.float32)), axis=1)
    Ft = jnp.transpose(F, (0, 2, 1))
    outs = []
    for blk in range(S // Q_BLOCK):
        q0, q1 = blk * Q_BLOCK, (blk + 1) * Q_BLOCK
        logits = jnp.einsum('bqhd,bkhd->bhqk', q[:, q0:q1], k[:, :q1],
                            preferred_element_type=jnp.float32) * scale
        logits = logits + (Ft[:, :, q0:q1, None] - Ft[:, :, None, :q1])
        causal = jnp.arange(q0, q1)[:, None] >= jnp.arange(q1)[None, :]
        p = jax.nn.softmax(jnp.where(causal[None, None], logits, NEG), axis=-1)
        outs.append(jnp.einsum('bhqk,bkhd->bqhd', p.astype(v.dtype), v[:, :q1]))
    return jnp.concatenate(outs, axis=1)


def dilated_window_attention(q, k, v, dilation, span):
    B, S, H, Dh = q.shape
    L = S // dilation
    nb = -(-L // span)
    Lp = nb * span
    Z = B * dilation
    scale = Dh ** -0.5

    def to_sub(t):
        t = t.reshape(B, L, dilation, H, Dh).transpose(0, 2, 1, 3, 4).reshape(Z, L, H, Dh)
        t = jnp.pad(t, ((0, 0), (0, Lp - L), (0, 0), (0, 0)))
        return t.reshape(Z, nb, span, H, Dh)

    qb, kb, vb = to_sub(q), to_sub(k), to_sub(v)

    def band(t):
        prev = jnp.pad(t, ((0, 0), (1, 0), (0, 0), (0, 0), (0, 0)))[:, :-1]
        return jnp.concatenate([prev, t], axis=2)

    kband, vband = band(kb), band(vb)
    logits = jnp.einsum('znqhd,znkhd->znhqk', qb, kband,
                        preferred_element_type=jnp.float32) * scale
    qi = jnp.arange(span)[:, None] + span
    kj = jnp.arange(2 * span)[None, :]
    dist = qi - kj
    in_band = (dist >= 0) & (dist <= span)
    has_prev = (jnp.arange(nb)[:, None, None] > 0) | (kj >= span)[None]
    valid = in_band[None] & has_prev
    logits = jnp.where(valid[None, :, None], logits, NEG)
    m = jnp.max(logits, axis=-1, keepdims=True)
    p = jnp.exp(logits - m)
    s = jnp.sum(p, axis=-1)
    o = jnp.einsum('znhqk,znkhd->znqhd', p.astype(v.dtype), vband).astype(jnp.float32)
    o = o / jnp.transpose(s, (0, 1, 3, 2))[..., None]
    lse = jnp.transpose(m[..., 0] + jnp.log(s), (0, 1, 3, 2))

    def from_sub(t):
        rest = t.shape[3:]
        t = t.reshape((Z, Lp) + rest)[:, :L]
        t = t.reshape((B, dilation, L) + rest)
        t = jnp.swapaxes(t, 1, 2)
        return t.reshape((B, S) + rest)

    return from_sub(o), from_sub(lse)


def hybrid_mixer(h, w_in, b_fgate, w_br_a, w_br_b, w_out):
    B, S, _ = h.shape
    proj = jnp.einsum('bsd,de->bse', h, w_in)
    splits = [int(i) for i in np.cumsum(SPLIT_SIZES)[:-1]]
    qa, ka, va, fa, qb, kb, vb, ga, gb = jnp.split(proj, splits, axis=-1)

    qa = qa.reshape(B, S, N_FOX_HEADS, HEAD_DIM)
    ka = ka.reshape(B, S, N_FOX_HEADS, HEAD_DIM)
    va = va.reshape(B, S, N_FOX_HEADS, HEAD_DIM)
    ya = forgetting_attention(qa, ka, va, fa + b_fgate)
    ya = jnp.einsum('bse,ed->bsd', ya.reshape(B, S, FOX_W), w_br_a)

    qb = partial_rope(qb.reshape(B, S, N_DIL_HEADS, HEAD_DIM))
    kb = partial_rope(kb.reshape(B, S, N_DIL_HEADS, HEAD_DIM))
    vb = vb.reshape(B, S, N_DIL_HEADS, HEAD_DIM)
    outs, lses = [], []
    for g, (window, dilation) in enumerate(DIL_GROUPS):
        sl = slice(g * N_DIL_HEADS_PER_GROUP, (g + 1) * N_DIL_HEADS_PER_GROUP)
        o, lse = dilated_window_attention(qb[:, :, sl], kb[:, :, sl], vb[:, :, sl],
                                          dilation, window // dilation)
        outs.append(o)
        lses.append(lse)
    alpha = jax.nn.softmax(jnp.stack(lses, axis=0), axis=0)
    yb = jnp.sum(alpha[..., None] * jnp.stack(outs, axis=0), axis=0).astype(h.dtype)
    yb = jnp.einsum('bse,ed->bsd', yb.reshape(B, S, DIL_OUT_W), w_br_b)

    merged = jax.nn.sigmoid(ga) * ya + jax.nn.sigmoid(gb) * yb
    return jnp.einsum('bsd,de->bse', merged, w_out)


def swiglu(h, w_gate, w_up, w_down):
    a = jnp.einsum('bsd,df->bsf', h, w_gate)
    u = jnp.einsum('bsd,df->bsf', h, w_up)
    return jnp.einsum('bsf,fd->bsd', jax.nn.silu(a) * u, w_down)


def setup_inputs(seed: int = 0) -> dict:
    key = jax.random.key(seed)
    ks = jax.random.split(key, 16)
    f32 = jnp.float32
    L, D = DEPTH, D_MODEL
    nrm = lambda k, shape, fan_in, s=1.0: (jax.random.normal(k, shape, f32) * (s * fan_in ** -0.5))
    return {
        "x": jax.random.normal(ks[0], (BATCH, SEQ, D), f32),
        "c": jax.random.normal(ks[1], (BATCH, D), f32),
        "w_ada": nrm(ks[2], (L, D, 6 * D), D, 0.5),
        "b_ada": 0.1 * jax.random.normal(ks[3], (L, 6 * D), f32),
        "g_mix": 1.0 + 0.02 * jax.random.normal(ks[4], (L, D), f32),
        "w_in": nrm(ks[5], (L, D, IN_COLS), D),
        "b_fgate": jax.random.uniform(ks[6], (L, N_FOX_HEADS), f32, 1.0, 4.0),
        "w_br_a": nrm(ks[7], (L, FOX_W, D), FOX_W),
        "w_br_b": nrm(ks[8], (L, DIL_OUT_W, D), DIL_OUT_W),
        "w_out": nrm(ks[9], (L, D, D), D),
        "g_ffn": 1.0 + 0.02 * jax.random.normal(ks[10], (L, D), f32),
        "w_ffn_gate": nrm(ks[11], (L, D, D_FF), D),
        "w_ffn_up": nrm(ks[12], (L, D, D_FF), D),
        "w_ffn_down": nrm(ks[13], (L, D_FF, D), D_FF),
        "g_final": 1.0 + 0.02 * jax.random.normal(ks[14], (D,), f32),
    }


def reference(x, c, w_ada, b_ada, g_mix, w_in, b_fgate, w_br_a, w_br_b, w_out,
              g_ffn, w_ffn_gate, w_ffn_up, w_ffn_down, g_final):
    for l in range(DEPTH):
        mod = jnp.einsum('bd,de->be', jax.nn.silu(c), w_ada[l]) + b_ada[l]
        sh_m, sc_m, ga_m, sh_f, sc_f, ga_f = jnp.split(mod, 6, axis=-1)
        h = modulate(rmsnorm(x, g_mix[l]), sh_m, sc_m)
        x = x + ga_m[:, None, :] * hybrid_mixer(h, w_in[l], b_fgate[l], w_br_a[l], w_br_b[l], w_out[l])
        h = modulate(rmsnorm(x, g_ffn[l]), sh_f, sc_f)
        x = x + ga_f[:, None, :] * swiglu(h, w_ffn_gate[l], w_ffn_up[l], w_ffn_down[l])
    return rmsnorm(x, g_final)
```

```cpp
#include <hip/hip_runtime.h>
#include <cstdio>
#include <cstdint>

typedef unsigned short bf16_t;
constexpr int D = 1024, BATCH = 8, SEQ = 2048, M = BATCH * SEQ;
constexpr int FOX_W = 512, DIL_W = 768, DIL_OUT_W = 256, D_FF = 2816, IN_COLS = 5896;
constexpr int C_QA = 0, C_KA = 512, C_VA = 1024, C_FA = 1536, C_QB = 1544, C_KB = 2312, C_VB = 3080, C_GA = 3848, C_GB = 4872;
constexpr float EPS = 1e-6f;

__device__ __forceinline__ float bf2f(bf16_t h) { return __uint_as_float(((unsigned)h) << 16); }
__device__ __forceinline__ bf16_t f2bf(float f) { unsigned u = __float_as_uint(f); u += 0x7fffu + ((u >> 16) & 1u); return (bf16_t)(u >> 16); }
__device__ __forceinline__ float wave_sum(float v) {
#pragma unroll
    for (int o = 1; o < 64; o <<= 1) v += __shfl_xor(v, o);
    return v;
}
__device__ __forceinline__ float sigmoidf_(float x) { return 1.f / (1.f + __expf(-x)); }

constexpr size_t MiB = 1u << 20;
constexpr size_t WS_MOD = 1 * MiB;
constexpr size_t WS_ROPE = WS_MOD + 256 * 1024;
constexpr size_t WS_LF = 2 * MiB;
constexpr size_t WS_XN = 36 * MiB;
constexpr size_t WS_YA = 36 * MiB, WS_YB = 52 * MiB;
constexpr size_t WS_FOX = 68 * MiB;
constexpr size_t WS_DIL = WS_FOX + 48 * MiB;
constexpr size_t WS_GATE = WS_DIL + 72 * MiB;
constexpr size_t WS_END = WS_GATE + 64 * MiB;
constexpr size_t WS_MERGED = WS_FOX, WS_ACT = WS_FOX, WS_H2 = WS_XN;

__global__ void k_mod(const float* __restrict__ c, const float* __restrict__ w_ada, const float* __restrict__ b_ada, float* __restrict__ mod) {
    const int e = blockIdx.x * 256 + threadIdx.x, b = blockIdx.y;
    float acc = 0.f;
    for (int d = 0; d < D; ++d) { const float cv = c[b * D + d]; acc += (cv / (1.f + __expf(-cv))) * w_ada[(size_t)d * 6144 + e]; }
    mod[b * 6144 + e] = acc + b_ada[e];
}
__global__ void k_rope_table(float* __restrict__ tab) {
    const int i = blockIdx.x * 256 + threadIdx.x; if (i >= SEQ * 8) return;
    const int pos = i >> 3, j = i & 7;
    const float IF[8] = {1.0f, 0.19392274474868576f, 0.03760603093086393f, 0.007292664737217109f, 0.001414213562373095f, 0.0002742481756762073f, 5.318295896944988e-05f, 1.031338537721246e-05f};
    float inv_freq = IF[0];
#pragma unroll
    for (int q = 1; q < 8; ++q) inv_freq = (j == q) ? IF[q] : inv_freq;
    const float ang = (float)pos * inv_freq;
    const double a = (double)ang;
    const double k = rint(a * 0.15915494309189535);
    const float r = (float)(a - k * 6.283185307179586);
    tab[i * 2 + 0] = __cosf(r); tab[i * 2 + 1] = __sinf(r);
}
__global__ __launch_bounds__(256) void k_norm_mod(const float* __restrict__ x, const float* __restrict__ g, const float* __restrict__ mod,
                                                  bf16_t* __restrict__ out, const float* __restrict__ w_in, const float* __restrict__ b_fgate, float* __restrict__ lf, int sh_off, int sc_off) {
    const int row = blockIdx.x * 4 + (threadIdx.x >> 6), lane = threadIdx.x & 63, b = row / SEQ;
    const float* xr = x + (size_t)row * D;
    float v[16]; float ss = 0.f;
#pragma unroll
    for (int j = 0; j < 16; ++j) { v[j] = xr[lane + 64 * j]; ss += v[j] * v[j]; }
    ss = wave_sum(ss);
    const float rstd = 1.0f / sqrtf(ss * (1.f / D) + EPS);
    float fa[8];
#pragma unroll
    for (int h = 0; h < 8; ++h) fa[h] = 0.f;
#pragma unroll
    for (int j = 0; j < 16; ++j) {
        const int col = lane + 64 * j;
        const float hv = v[j] * rstd * g[col] * (1.f + mod[b * 6144 + sc_off + col]) + mod[b * 6144 + sh_off + col];
        out[(size_t)row * D + col] = f2bf(hv);
        if (lf) {
#pragma unroll
            for (int h = 0; h < 8; ++h) fa[h] += hv * w_in[(size_t)col * IN_COLS + C_FA + h];
        }
    }
    if (lf) {
#pragma unroll
        for (int h = 0; h < 8; ++h) {
            const float s = wave_sum(fa[h]) + b_fgate[h];
            const float ls = fminf(s, 0.f) - log1pf(__expf(-fabsf(s)));
            if (lane == 0) lf[(size_t)row * 8 + h] = ls;
        }
    }
}
__global__ void k_cumsum(float* __restrict__ lf) {
    const int i = threadIdx.x, b = i >> 3, h = i & 7; float s = 0.f;
    for (int t = 0; t < SEQ; ++t) { const size_t o = ((size_t)(b * SEQ + t)) * 8 + h; s += lf[o]; lf[o] = s; }
}

template <class Epi, bool DUAL>
__global__ __launch_bounds__(256) void ngemm(const bf16_t* __restrict__ A, const float* __restrict__ W, const float* __restrict__ W2, int lda, int ldw, int K, int pad_, Epi epi) {
    __shared__ float As[16][68];
    __shared__ float Bs[16][64];
    __shared__ float Bs2[16][64];
    const int tx = threadIdx.x & 15, ty = threadIdx.x >> 4;
    const int row0 = blockIdx.y * 64, col0 = blockIdx.x * 64;
    float acc[4][4], acc2[4][4];
#pragma unroll
    for (int i = 0; i < 4; ++i)
#pragma unroll
        for (int j = 0; j < 4; ++j) { acc[i][j] = 0.f; acc2[i][j] = 0.f; }
    for (int k0 = 0; k0 < K; k0 += 16) {
        { const int r = threadIdx.x >> 2, kk = (threadIdx.x & 3) * 4; const bf16_t* p = A + (size_t)(row0 + r) * lda + k0 + kk;
#pragma unroll
          for (int i = 0; i < 4; ++i) As[kk + i][r] = bf2f(p[i]); }
        { const int kk = threadIdx.x >> 4, c = (threadIdx.x & 15) * 4; const float* p = W + (size_t)(k0 + kk) * ldw + col0 + c;
#pragma unroll
          for (int i = 0; i < 4; ++i) Bs[kk][c + i] = p[i];
          if (DUAL) { const float* p2 = W2 + (size_t)(k0 + kk) * ldw + col0 + c;
#pragma unroll
              for (int i = 0; i < 4; ++i) Bs2[kk][c + i] = p2[i]; } }
        __syncthreads();
#pragma unroll
        for (int kk = 0; kk < 16; ++kk) {
            float a[4], bb[4], b2[4];
#pragma unroll
            for (int i = 0; i < 4; ++i) { a[i] = As[kk][ty * 4 + i]; bb[i] = Bs[kk][tx * 4 + i]; b2[i] = DUAL ? Bs2[kk][tx * 4 + i] : 0.f; }
#pragma unroll
            for (int i = 0; i < 4; ++i)
#pragma unroll
                for (int j = 0; j < 4; ++j) { acc[i][j] += a[i] * bb[j]; if (DUAL) acc2[i][j] += a[i] * b2[j]; }
        }
        __syncthreads();
    }
#pragma unroll
    for (int i = 0; i < 4; ++i)
#pragma unroll
        for (int j = 0; j < 4; ++j) epi(row0 + ty * 4 + i, col0 + tx * 4 + j, acc[i][j], acc2[i][j]);
}
struct EpiStoreBf16 { bf16_t* O; int ldo; int pad; __device__ void operator()(int r, int c, float v, float) const { O[(size_t)r * ldo + c] = f2bf(v); } };
struct EpiGateA { float* T; const bf16_t* ga; __device__ void operator()(int r, int c, float v, float) const { T[(size_t)r * D + c] = sigmoidf_(bf2f(ga[(size_t)r * D + c])) * v; } };
struct EpiGateB { const float* T; const bf16_t* gb; bf16_t* O; __device__ void operator()(int r, int c, float v, float) const { O[(size_t)r * D + c] = f2bf(T[(size_t)r * D + c] + sigmoidf_(bf2f(gb[(size_t)r * D + c])) * v); } };
struct EpiResid { const float* base; const float* mod; float* out; int g_off; int pad; __device__ void operator()(int r, int c, float v, float) const { const int b = r / SEQ; out[(size_t)r * D + c] = base[(size_t)r * D + c] + mod[b * 6144 + g_off + c] * v; } };
struct EpiSwiglu { bf16_t* O; __device__ void operator()(int r, int c, float a, float u) const { O[(size_t)r * D_FF + c] = f2bf((a / (1.f + __expf(-a))) * u); } };

__global__ void k_rope(bf16_t* __restrict__ T, const float* __restrict__ tab) {
    const int i = blockIdx.x * 256 + threadIdx.x;
    if (i >= M * 12 * 8) return;
    const int j = i & 7, head = (i >> 3) % 12, row = i / 96, pos = row % SEQ;
    bf16_t* p = T + (size_t)row * DIL_W + head * 64;
    const float x1 = bf2f(p[j]), x2 = bf2f(p[j + 8]), c = tab[(pos * 8 + j) * 2], s = tab[(pos * 8 + j) * 2 + 1];
    p[j] = f2bf(x1 * c - x2 * s); p[j + 8] = f2bf(x2 * c + x1 * s);
}
__global__ __launch_bounds__(256) void k_fox(const bf16_t* __restrict__ Q, const bf16_t* __restrict__ Kb, const bf16_t* __restrict__ V, const float* __restrict__ Fc, bf16_t* __restrict__ ya) {
    const int w = blockIdx.x * 4 + (threadIdx.x >> 6), lane = threadIdx.x & 63;
    const int t = w % SEQ, h = (w / SEQ) % 8, b = w / (SEQ * 8);
    const size_t rowq = (size_t)(b * SEQ + t);
    const float q = bf2f(Q[rowq * FOX_W + h * 64 + lane]) * 0.125f;
    const float Ft = Fc[rowq * 8 + h];
    float m = -1e30f, l = 0.f, o = 0.f;
    for (int s = 0; s <= t; ++s) {
        const size_t rs = (size_t)(b * SEQ + s);
        const float kv = bf2f(Kb[rs * FOX_W + h * 64 + lane]), vv = bf2f(V[rs * FOX_W + h * 64 + lane]);
        const float logit = wave_sum(q * kv) + (Ft - Fc[rs * 8 + h]);
        const float mn = fmaxf(m, logit), a = __expf(m - mn), p = __expf(logit - mn);
        l = l * a + p; o = o * a + p * vv; m = mn;
    }
    ya[rowq * FOX_W + h * 64 + lane] = f2bf(o / l);
}
__global__ __launch_bounds__(256) void k_dil(const bf16_t* __restrict__ Q, const bf16_t* __restrict__ Kb, const bf16_t* __restrict__ V, bf16_t* __restrict__ yb) {
    const int w = blockIdx.x * 4 + (threadIdx.x >> 6), lane = threadIdx.x & 63;
    const int t = w % SEQ, hs = (w / SEQ) % 4, b = w / (SEQ * 4);
    const size_t rowq = (size_t)(b * SEQ + t);
    float og[3], lse[3];
#pragma unroll
    for (int g = 0; g < 3; ++g) {
        const int dil = g == 0 ? 1 : (g == 1 ? 4 : 16), head = g * 4 + hs;
        const float q = bf2f(Q[rowq * DIL_W + head * 64 + lane]) * 0.125f;
        float m = -1e30f, l = 0.f, o = 0.f;
        for (int j = 0; j <= 128; ++j) {
            const int s = t - j * dil; if (s < 0) break;
            const size_t rs = (size_t)(b * SEQ + s);
            const float kv = bf2f(Kb[rs * DIL_W + head * 64 + lane]), vv = bf2f(V[rs * DIL_W + head * 64 + lane]);
            const float logit = wave_sum(q * kv);
            const float mn = fmaxf(m, logit), a = __expf(m - mn), p = __expf(logit - mn);
            l = l * a + p; o = o * a + p * vv; m = mn;
        }
        og[g] = o / l; lse[g] = m + __logf(l);
    }
    const float mx = fmaxf(lse[0], fmaxf(lse[1], lse[2]));
    const float w0 = __expf(lse[0] - mx), w1 = __expf(lse[1] - mx), w2 = __expf(lse[2] - mx);
    yb[rowq * DIL_OUT_W + hs * 64 + lane] = f2bf((w0 * og[0] + w1 * og[1] + w2 * og[2]) / (w0 + w1 + w2));
}
__global__ __launch_bounds__(256) void k_final(float* __restrict__ x, const float* __restrict__ g) {
    const int row = blockIdx.x * 4 + (threadIdx.x >> 6), lane = threadIdx.x & 63;
    float* xr = x + (size_t)row * D; float v[16]; float ss = 0.f;
#pragma unroll
    for (int j = 0; j < 16; ++j) { v[j] = xr[lane + 64 * j]; ss += v[j] * v[j]; }
    ss = wave_sum(ss);
    const float rstd = 1.0f / sqrtf(ss * (1.f / D) + EPS);
#pragma unroll
    for (int j = 0; j < 16; ++j) xr[lane + 64 * j] = v[j] * rstd * g[lane + 64 * j];
}

extern "C" void kernel_launch(void* const* d_in, const int* in_sizes, int n_in, void* d_out, int out_size, void* d_ws, size_t ws_size, hipStream_t stream) {
    if (n_in != 15 || ws_size < WS_END || out_size != M * D) { fprintf(stderr, "kernel_launch: unexpected shapes (n_in %d ws %zu out %d)\n", n_in, ws_size, out_size); return; }
    const float* x = (const float*)d_in[0]; const float* c = (const float*)d_in[1]; const float* w_ada = (const float*)d_in[2]; const float* b_ada = (const float*)d_in[3];
    const float* g_mix = (const float*)d_in[4]; const float* w_in = (const float*)d_in[5]; const float* b_fgate = (const float*)d_in[6]; const float* w_br_a = (const float*)d_in[7];
    const float* w_br_b = (const float*)d_in[8]; const float* w_out = (const float*)d_in[9]; const float* g_ffn = (const float*)d_in[10]; const float* w_gate = (const float*)d_in[11];
    const float* w_up = (const float*)d_in[12]; const float* w_down = (const float*)d_in[13]; const float* g_final = (const float*)d_in[14];
    float* out = (float*)d_out; unsigned char* ws = (unsigned char*)d_ws;
    float* mod = (float*)(ws + WS_MOD); float* rope = (float*)(ws + WS_ROPE); float* lf = (float*)(ws + WS_LF);
    bf16_t* XN = (bf16_t*)(ws + WS_XN); bf16_t* YA = (bf16_t*)(ws + WS_YA); bf16_t* YB = (bf16_t*)(ws + WS_YB);
    bf16_t* QA = (bf16_t*)(ws + WS_FOX); bf16_t* KA = QA + (size_t)M * FOX_W; bf16_t* VA = KA + (size_t)M * FOX_W;
    bf16_t* QB = (bf16_t*)(ws + WS_DIL); bf16_t* KB = QB + (size_t)M * DIL_W; bf16_t* VB = KB + (size_t)M * DIL_W;
    bf16_t* GA = (bf16_t*)(ws + WS_GATE); bf16_t* GB = GA + (size_t)M * D;
    bf16_t* MERGED = (bf16_t*)(ws + WS_MERGED); bf16_t* ACT = (bf16_t*)(ws + WS_ACT); bf16_t* H2 = (bf16_t*)(ws + WS_H2);

    k_mod<<<dim3(6144 / 256, BATCH), 256, 0, stream>>>(c, w_ada, b_ada, mod);
    k_rope_table<<<SEQ * 8 / 256, 256, 0, stream>>>(rope);
    k_norm_mod<<<M / 4, 256, 0, stream>>>(x, g_mix, mod, XN, w_in, b_fgate, lf, 0, 1024);
    k_cumsum<<<1, 64, 0, stream>>>(lf);
    const int offs[8] = {C_QA, C_KA, C_VA, C_QB, C_KB, C_VB, C_GA, C_GB}; bf16_t* dst[8] = {QA, KA, VA, QB, KB, VB, GA, GB}; const int wid[8] = {512, 512, 512, 768, 768, 768, 1024, 1024};
    for (int i = 0; i < 8; ++i)
        ngemm<EpiStoreBf16, false><<<dim3(wid[i] / 64, M / 64), 256, 0, stream>>>(XN, w_in + offs[i], nullptr, D, IN_COLS, D, 0, EpiStoreBf16{dst[i], wid[i], 0});
    k_rope<<<M * 96 / 256, 256, 0, stream>>>(QB, rope);
    k_rope<<<M * 96 / 256, 256, 0, stream>>>(KB, rope);
    k_fox<<<BATCH * 8 * SEQ / 4, 256, 0, stream>>>(QA, KA, VA, lf, YA);
    k_dil<<<BATCH * 4 * SEQ / 4, 256, 0, stream>>>(QB, KB, VB, YB);
    ngemm<EpiGateA, false><<<dim3(D / 64, M / 64), 256, 0, stream>>>(YA, w_br_a, nullptr, FOX_W, D, FOX_W, 0, EpiGateA{out, GA});
    ngemm<EpiGateB, false><<<dim3(D / 64, M / 64), 256, 0, stream>>>(YB, w_br_b, nullptr, DIL_OUT_W, D, DIL_OUT_W, 0, EpiGateB{out, GB, MERGED});
    ngemm<EpiResid, false><<<dim3(D / 64, M / 64), 256, 0, stream>>>(MERGED, w_out, nullptr, D, D, D, 0, EpiResid{x, mod, out, 2048, 0});
    k_norm_mod<<<M / 4, 256, 0, stream>>>(out, g_ffn, mod, H2, nullptr, nullptr, nullptr, 3072, 4096);
    ngemm<EpiSwiglu, true><<<dim3(D_FF / 64, M / 64), 256, 0, stream>>>(H2, w_gate, w_up, D, D_FF, D, 0, EpiSwiglu{ACT});
    ngemm<EpiResid, false><<<dim3(D / 64, M / 64), 256, 0, stream>>>(ACT, w_down, nullptr, D_FF, D, D_FF, 0, EpiResid{out, mod, out, 5120, 0});
    k_final<<<M / 4, 256, 0, stream>>>(out, g_final);
}
```

```cpp
#include <hip/hip_runtime.h>
#include <cstdio>
#include <cstdint>
namespace pg8 {
#define PG8_LAS __attribute__((address_space(3)))
typedef unsigned short bf16_t;
typedef short bf16x8 __attribute__((ext_vector_type(8)));
typedef float f32x4 __attribute__((ext_vector_type(4)));
typedef unsigned u32x4 __attribute__((ext_vector_type(4)));
constexpr int BM = 256, BK = 64, HALF = 128, HTB = HALF * BK * 2  , STAGE_BYTES = 8 * HTB, NXCD = 8, WGM = 8;

__host__ __device__ __forceinline__ int lds_byte(int r, int c) { const int st = (r >> 4) * 2 + (c >> 5), rr = r & 15, cc = c & 31, ob = rr * 64 + cc * 2; return st * 1024 + (ob ^ (((ob >> 9) & 1) << 5)); }
__host__ __device__ __forceinline__ void stage_rc(int b, int& R, int& C) { const int st = b / 1024, sb = b % 1024, swz = sb ^ (((sb >> 9) & 1) << 5); R = (st >> 1) * 16 + swz / 64; C = (st & 1) * 32 + (swz % 64) / 2; }
__host__ __device__ __forceinline__ int perm32(int rho) { const int n = rho >> 4, i = rho & 15; return 8 * (i >> 2) + 4 * n + (i & 3); }

struct Unit { int pm, pn; };
struct Gemm { const bf16_t* A; const bf16_t* Bt; int M, N, K; };

struct StaticOrder {
    int nM, nN, nwg, G, c;
    __host__ __device__ void init(int M, int N, int G_, int c_) { nM = M / BM; nN = N / BM; nwg = nM * nN; G = G_; c = c_; }
    __host__ __device__ bool next(int i, Unit& u) const {
        const long L = (long)i * G + c; if (L >= nwg) return false;
        int wgid = (int)L; { const int q = nwg / NXCD, r = nwg % NXCD, xcd = wgid % NXCD, off = wgid / NXCD; wgid = (xcd < r ? xcd * (q + 1) : r * (q + 1) + (xcd - r) * q) + off; }
        const int nig = WGM * nN, gid = wgid / nig, fm = gid * WGM, gsz = (nM - fm) < WGM ? (nM - fm) : WGM;
        u.pm = fm + ((wgid % nig) % gsz); u.pn = (wgid % nig) / gsz; return true;
    }
    __device__ __forceinline__ void a_ready(const Unit&) const {}
    __device__ __forceinline__ void done(const Unit&) const {}
};

__device__ __forceinline__ unsigned cvt_pk_bf16(float lo, float hi) { unsigned r; asm volatile("v_cvt_pk_bf16_f32 %0, %1, %2" : "=v"(r) : "v"(lo), "v"(hi)); return r; }
typedef float f32x2 __attribute__((ext_vector_type(2)));
__device__ __forceinline__ f32x2 gelu_pk(f32x2 v) {
    const f32x2 av = __builtin_elementwise_abs(v), d = av * 0.2316418882f + 1.0f;
    f32x2 t; t.x = __builtin_amdgcn_rcpf(d.x); t.y = __builtin_amdgcn_rcpf(d.y);
    f32x2 q = t * 0.5307027145f + (-0.7265760135f); q = q * t + 0.7107068705f; q = q * t + (-0.142248368f); q = q * t + 0.127414796f; q = q * t;
    const f32x2 s = (v * v) * (-0.72134752044f);
    f32x2 e; e.x = __builtin_amdgcn_exp2f(s.x); e.y = __builtin_amdgcn_exp2f(s.y);
    const f32x2 m = v * (q * e), r = v - m;
    f32x2 o; o.x = v.x < 0.f ? m.x : r.x; o.y = v.y < 0.f ? m.y : r.y; return o;
}

template <int ACT  > struct EpiBf16 {
    static constexpr bool PERM = true, AFTER_DRAIN = false; static_assert(ACT == 0 || ACT == 1, "EpiBf16: ACT is 0 (none) or 1 (gelu_pk)");
    bf16_t* O; int ldc; const float* bias; int split_cols; size_t split_stride; float scale0;
    __device__ __forceinline__ void operator()(const f32x4 (&acc)[2][2][4][2], const Unit& u, int wr, int wc, int fr, int fq) const {
        const int row0 = u.pm * BM + wr * 64 + fr; int colt = u.pn * BM; bf16_t* base = O;
        float sc = 1.f; if (split_cols) { const int t = colt / split_cols; base += (size_t)t * split_stride; colt -= t * split_cols; if (t == 0) sc = scale0; }
        const int col0 = colt + wc * 32 + 8 * fq, bcol0 = u.pn * BM + wc * 32 + 8 * fq;
        f32x4 bv[2][2];
#pragma unroll
        for (int bj = 0; bj < 2; ++bj)
#pragma unroll
            for (int n = 0; n < 2; ++n) bv[bj][n] = bias ? *(const f32x4*)(bias + bcol0 + bj * HALF + 4 * n) : (f32x4){0.f, 0.f, 0.f, 0.f};
#pragma unroll
        for (int ai = 0; ai < 2; ++ai)
#pragma unroll
            for (int m = 0; m < 4; ++m) { bf16_t* rowp = base + (size_t)(row0 + ai * HALF + m * 16) * ldc + col0;
#pragma unroll
                for (int bj = 0; bj < 2; ++bj) { f32x4 v0 = acc[ai][bj][m][0] + bv[bj][0], v1 = acc[ai][bj][m][1] + bv[bj][1];
                    if (ACT == 1) { f32x2 a = gelu_pk((f32x2){v0[0], v0[1]}), b = gelu_pk((f32x2){v0[2], v0[3]}), c = gelu_pk((f32x2){v1[0], v1[1]}), d = gelu_pk((f32x2){v1[2], v1[3]});
                        v0 = (f32x4){a.x, a.y, b.x, b.y}; v1 = (f32x4){c.x, c.y, d.x, d.y}; }
                    v0 = v0 * sc; v1 = v1 * sc; u32x4 w; w.x = cvt_pk_bf16(v0[0], v0[1]); w.y = cvt_pk_bf16(v0[2], v0[3]); w.z = cvt_pk_bf16(v1[0], v1[1]); w.w = cvt_pk_bf16(v1[2], v1[3]);
                    *(u32x4*)(rowp + bj * HALF) = w; } }
    }
};
template <class Epi, class Sched, bool ALIGN_EPI = false, bool SP2 = false>
__device__ __forceinline__ void gemm_phase(PG8_LAS unsigned char* lds, const Gemm g, const Sched& S, const Epi& E) {
    int tid_ = threadIdx.x; asm volatile("" : "+v"(tid_));
    const int tid = tid_, wid = __builtin_amdgcn_readfirstlane(tid >> 6), lane = tid & 63, wr = wid >> 2, wc = wid & 3, fr = lane & 15, fq = lane >> 4;
    const int K = g.K, nt = K / BK;
    unsigned voffA[2], voffB[2];
#pragma unroll
    for (int i = 0; i < 2; ++i) { int R, C; stage_rc(tid * 16 + i * 8192, R, C); const int Rb = Epi::PERM ? ((R & ~31) + perm32(R & 31)) : R;
        voffA[i] = (unsigned)(R * K + C) * 2u; voffB[i] = (unsigned)(Rb * K + C) * 2u; }
    const size_t kstep = (size_t)(BK * 2);
    const size_t hstep = (size_t)HALF * K * 2;
    const size_t tstep = 2 * hstep;
    const unsigned ldsw = (unsigned)wid * 1024u;
    const int aoff = lds_byte(wr * 64 + fr, fq * 8), boff = lds_byte(wc * 32 + fr, fq * 8);
#define PG8_SA(b, h) (((b) * 2 + (h)) * HTB)
#define PG8_SB(b, h) ((4 + (b) * 2 + (h)) * HTB)
#define PG8_STAGE(bufoff, gbase, voff) do { _Pragma("unroll") for (int _i = 0; _i < 2; ++_i) \
        __builtin_amdgcn_global_load_lds((const unsigned*)((const char*)(gbase) + (voff)[_i]), (PG8_LAS unsigned*)(lds + (bufoff) + ldsw + _i * 8192), 16, 0, 0); } while (0)
#define PG8_LDA(dst, b, h) do { _Pragma("unroll") for (int m = 0; m < 4; ++m) _Pragma("unroll") for (int k = 0; k < 2; ++k) dst[m][k] = *(const PG8_LAS bf16x8*)(lds + PG8_SA(b, h) + aoff + m * 2048 + k * 1024); } while (0)
#define PG8_LDB(dst, b, h) do { _Pragma("unroll") for (int n = 0; n < 2; ++n) _Pragma("unroll") for (int k = 0; k < 2; ++k) dst[n][k] = *(const PG8_LAS bf16x8*)(lds + PG8_SB(b, h) + boff + n * 2048 + k * 1024); } while (0)
#define PG8_MMA(ai, bj, At, Bt) do { __builtin_amdgcn_s_setprio(1); _Pragma("unroll") for (int m = 0; m < 4; ++m) _Pragma("unroll") for (int n = 0; n < 2; ++n) _Pragma("unroll") for (int k = 0; k < 2; ++k) \
        acc[ai][bj][m][n] = __builtin_amdgcn_mfma_f32_16x16x32_bf16(Bt[n][k], At[m][k], acc[ai][bj][m][n], 0, 0, 0); __builtin_amdgcn_s_setprio(0); } while (0)
#define PG8_WAIT_V(n) asm volatile("s_waitcnt vmcnt(" #n ")" ::: "memory")
#define PG8_WAIT_L(n) asm volatile("s_waitcnt lgkmcnt(" #n ")" ::: "memory")
#define PG8_BAR __builtin_amdgcn_s_barrier()
#define PG8_SCHED __builtin_amdgcn_sched_barrier(0)
    Unit cur, nxt; int ui = 0;
    if (!S.next(0, cur)) return;
    f32x4 acc[2][2][4][2];
#pragma unroll
    for (int a = 0; a < 2; ++a)
#pragma unroll
        for (int b = 0; b < 2; ++b)
#pragma unroll
            for (int m = 0; m < 4; ++m)
#pragma unroll
                for (int n = 0; n < 2; ++n) acc[a][b][m][n] = (f32x4){0.f, 0.f, 0.f, 0.f};
    bf16x8 At[4][2], B0[2][2], B1[2][2];
    const char* cA = (const char*)g.A + (size_t)cur.pm * tstep; const char* cB = (const char*)g.Bt + (size_t)cur.pn * tstep;
    S.a_ready(cur);
    if constexpr (SP2) {
        PG8_STAGE(PG8_SB(0, 0), cB, voffB); PG8_STAGE(PG8_SB(0, 1), cB + hstep, voffB); PG8_STAGE(PG8_SA(0, 0), cA, voffA); PG8_STAGE(PG8_SA(0, 1), cA + hstep, voffA);
        if (wr == 1) PG8_BAR;
        PG8_WAIT_V(2); PG8_BAR;
        PG8_STAGE(PG8_SB(1, 0), cB + kstep, voffB); PG8_STAGE(PG8_SA(1, 0), cA + kstep, voffA); PG8_STAGE(PG8_SB(1, 1), cB + hstep + kstep, voffB);
        PG8_WAIT_V(6); PG8_BAR;
    } else {
        PG8_STAGE(PG8_SB(0, 0), cB, voffB); PG8_STAGE(PG8_SA(0, 0), cA, voffA); PG8_STAGE(PG8_SB(0, 1), cB + hstep, voffB); PG8_STAGE(PG8_SA(0, 1), cA + hstep, voffA);
        if (wr == 1) PG8_BAR;
        PG8_WAIT_V(4); PG8_BAR;
        PG8_STAGE(PG8_SB(1, 0), cB + kstep, voffB); PG8_STAGE(PG8_SA(1, 0), cA + kstep, voffA); PG8_STAGE(PG8_SB(1, 1), cB + hstep + kstep, voffB);
        PG8_WAIT_V(6); PG8_BAR;
    }
    for (;;) {
        const bool has_next = S.next(ui + 1, nxt);
        const char* nA = has_next ? (const char*)g.A + (size_t)nxt.pm * tstep : cA; const char* nB = has_next ? (const char*)g.Bt + (size_t)nxt.pn * tstep : cB;
        for (int t = 0; t < nt; t += 2) {
            const bool last = (t == nt - 2);
            const char* a1 = cA + (size_t)(t + 1) * kstep;
            const char* a2 = last ? nA : cA + (size_t)(t + 2) * kstep; const char* b2 = last ? nB : cB + (size_t)(t + 2) * kstep;
            const char* a3 = a2 + kstep; const char* b3 = b2 + kstep;
            if (last && has_next) S.a_ready(nxt);
            if constexpr (SP2) {
            PG8_LDB(B0, 0, 0); PG8_LDB(B1, 0, 1); PG8_SCHED; PG8_LDA(At, 0, 0); PG8_STAGE(PG8_SA(1, 1), a1 + hstep, voffA);
            PG8_WAIT_V(8); PG8_WAIT_L(0); PG8_BAR; PG8_MMA(0, 0, At, B0); PG8_MMA(0, 1, At, B1); PG8_BAR; PG8_SCHED;
            PG8_LDA(At, 0, 1); PG8_STAGE(PG8_SB(0, 0), b2, voffB); PG8_STAGE(PG8_SB(0, 1), b2 + hstep, voffB); PG8_STAGE(PG8_SA(0, 0), a2, voffA);
            PG8_WAIT_V(8); PG8_WAIT_L(0); PG8_BAR; PG8_MMA(1, 0, At, B0); PG8_MMA(1, 1, At, B1); PG8_BAR; PG8_SCHED;
            PG8_LDB(B0, 1, 0); PG8_LDB(B1, 1, 1); PG8_SCHED; PG8_LDA(At, 1, 0); PG8_STAGE(PG8_SA(0, 1), a2 + hstep, voffA);
            PG8_WAIT_V(8); PG8_WAIT_L(0); PG8_BAR; PG8_MMA(0, 0, At, B0); PG8_MMA(0, 1, At, B1); PG8_BAR; PG8_SCHED;
            PG8_LDA(At, 1, 1); PG8_STAGE(PG8_SB(1, 0), b3, voffB); PG8_STAGE(PG8_SB(1, 1), b3 + hstep, voffB); PG8_STAGE(PG8_SA(1, 0), a3, voffA);
            PG8_WAIT_V(8); PG8_WAIT_L(0); PG8_BAR; PG8_MMA(1, 0, At, B0); PG8_MMA(1, 1, At, B1); PG8_BAR; PG8_SCHED;
            } else {
            PG8_LDB(B0, 0, 0); PG8_SCHED; PG8_LDA(At, 0, 0); PG8_STAGE(PG8_SA(1, 1), a1 + hstep, voffA);
            PG8_WAIT_L(8); PG8_BAR; PG8_WAIT_L(0); PG8_MMA(0, 0, At, B0); PG8_BAR; PG8_SCHED;
            PG8_LDB(B1, 0, 1); PG8_STAGE(PG8_SB(0, 0), b2, voffB);
            PG8_BAR; PG8_WAIT_L(0); PG8_MMA(0, 1, At, B1); PG8_BAR;
            PG8_LDA(At, 0, 1); PG8_STAGE(PG8_SA(0, 0), a2, voffA);
            PG8_BAR; PG8_WAIT_L(0); PG8_MMA(1, 0, At, B0); PG8_BAR; PG8_SCHED;
            PG8_STAGE(PG8_SB(0, 1), b2 + hstep, voffB);
            PG8_WAIT_V(6); PG8_BAR; PG8_MMA(1, 1, At, B1); PG8_BAR;
            PG8_LDB(B0, 1, 0); PG8_SCHED; PG8_LDA(At, 1, 0); PG8_STAGE(PG8_SA(0, 1), a2 + hstep, voffA);
            PG8_WAIT_L(8); PG8_BAR; PG8_WAIT_L(0); PG8_MMA(0, 0, At, B0); PG8_BAR; PG8_SCHED;
            PG8_LDB(B1, 1, 1); PG8_STAGE(PG8_SB(1, 0), b3, voffB);
            PG8_BAR; PG8_WAIT_L(0); PG8_MMA(0, 1, At, B1); PG8_BAR;
            PG8_LDA(At, 1, 1); PG8_STAGE(PG8_SA(1, 0), a3, voffA);
            PG8_BAR; PG8_WAIT_L(0); PG8_MMA(1, 0, At, B0); PG8_BAR; PG8_SCHED;
            PG8_STAGE(PG8_SB(1, 1), b3 + hstep, voffB);
            PG8_WAIT_V(6); PG8_BAR; PG8_MMA(1, 1, At, B1); PG8_BAR;
            }
        }
        if constexpr (ALIGN_EPI) { if (wr == 0) PG8_BAR; }
        if constexpr (!Epi::AFTER_DRAIN) { E(acc, cur, wr, wc, fr, fq); S.done(cur); }
        if (!has_next) break;
#pragma unroll
        for (int a = 0; a < 2; ++a)
#pragma unroll
            for (int b = 0; b < 2; ++b)
#pragma unroll
                for (int m = 0; m < 4; ++m)
#pragma unroll
                    for (int n = 0; n < 2; ++n) acc[a][b][m][n] = (f32x4){0.f, 0.f, 0.f, 0.f};
        cur = nxt; cA = nA; cB = nB; ++ui;
        if constexpr (ALIGN_EPI) { if (wr == 1) PG8_BAR; }
    }
    PG8_WAIT_V(0);
    if constexpr (!ALIGN_EPI) { if (wr == 0) PG8_BAR; }
    PG8_BAR;
    if constexpr (Epi::AFTER_DRAIN) { E.fused(acc, cur, wr, wc, fr, fq, lds, wid, lane); S.done(cur); }
#undef PG8_SA
#undef PG8_SB
#undef PG8_STAGE
#undef PG8_LDA
#undef PG8_LDB
#undef PG8_MMA
#undef PG8_WAIT_V
#undef PG8_WAIT_L
#undef PG8_BAR
#undef PG8_SCHED
}
}

#ifndef PG8_SP2
#define PG8_SP2 true
#endif
#ifndef PG8_ALIGN
#define PG8_ALIGN true
#endif
#define GAS __attribute__((address_space(1)))
#define LAS __attribute__((address_space(3)))
typedef unsigned short bf16;
typedef unsigned v4u __attribute__((ext_vector_type(4)));
typedef float f32x4 __attribute__((ext_vector_type(4)));
typedef short bf16x8 __attribute__((ext_vector_type(8)));
typedef GAS unsigned gu32;
typedef GAS unsigned long long gu64;
#define RLX_AGENT __ATOMIC_RELAXED, __HIP_MEMORY_SCOPE_AGENT
#define LDS_WAIT() asm volatile("s_waitcnt lgkmcnt(0)" ::: "memory")
#define VM_WAIT() asm volatile("s_waitcnt vmcnt(0)" ::: "memory")
__device__ __forceinline__ unsigned long long rt() { return __builtin_amdgcn_s_memrealtime(); }
__device__ __forceinline__ unsigned f2bf(float f) { unsigned u = __builtin_bit_cast(unsigned, f); return (u + 0x7fffu + ((u >> 16) & 1u)) >> 16; }
__device__ __forceinline__ unsigned pk2(float lo, float hi) { return f2bf(lo) | (f2bf(hi) << 16); }

#define XB_TMO      128
#define XB_XCNT(j)  (256  + 64 * (j))
#define XB_XSUB(j)  (1280 + 64 * (j))
#define XB_XGEN(j)  (2304 + 64 * (j))
#define XB_TOP      3328
#define XB_TOPGEN   3392
#define XCD_BAR_WORDS 3456
#define XB_SPIN_CAP (1u << 22)

__device__ __forceinline__ unsigned xb_ld(unsigned* p)              { return __hip_atomic_load(p, __ATOMIC_RELAXED, __HIP_MEMORY_SCOPE_AGENT); }
__device__ __forceinline__ unsigned xb_add(unsigned* p, unsigned v) { return __hip_atomic_fetch_add(p, v, __ATOMIC_RELAXED, __HIP_MEMORY_SCOPE_AGENT); }
__device__ __forceinline__ unsigned xb_xcc_id() { return (unsigned)__builtin_amdgcn_s_getreg((3 << 11) | 20) & 0xFu; }
#define XB_SPIN(cond, bar) do { unsigned _sp = 0; while (cond) { __builtin_amdgcn_s_sleep(1); \
    if ((++_sp & 255u) == 0u) { if (xb_ld(&(bar)[XB_TMO])) break; if (_sp > XB_SPIN_CAP) { atomicAdd(&(bar)[XB_TMO], 1u); break; } } } } while (0)

struct XcdBarrier {
    unsigned* bar; unsigned x;
    volatile LAS unsigned* st;
};

__device__ __forceinline__ XcdBarrier xcd_barrier_post(unsigned* bar, volatile LAS unsigned* st) {
    XcdBarrier b; b.bar = bar; b.x = xb_xcc_id(); b.st = st;
    if (threadIdx.x == 0) (void)xb_add(&bar[XB_XCNT(b.x)], 1u);
    return b;
}
__device__ __forceinline__ void xcd_barrier_complete(unsigned* bar, unsigned x, unsigned& nloc, unsigned& nx) {
    const unsigned G = gridDim.x * gridDim.y * gridDim.z;
    unsigned sum, cnt, mine, sp = 0u;
    for (;;) {
        sum = 0u; cnt = 0u; mine = 0u;
#pragma unroll
        for (unsigned j = 0; j < 16; ++j) { const unsigned c = xb_ld(&bar[XB_XCNT(j)]); sum += c; cnt += (c > 0u) ? 1u : 0u; mine = (j == x) ? c : mine; }
        if (sum == G) break;
        __builtin_amdgcn_s_sleep(1);
        if ((++sp & 255u) == 0u) { if (xb_ld(&bar[XB_TMO])) break; if (sp > XB_SPIN_CAP) { atomicAdd(&bar[XB_TMO], 1u); break; } }
    }
    nloc = mine > 0u ? mine : 1u; nx = cnt > 0u ? cnt : 1u;
}

__device__ __forceinline__ void xcd_barrier(const XcdBarrier& b) {
    asm volatile("s_waitcnt vmcnt(0)" ::: "memory");
    __syncthreads();
    if (threadIdx.x == 0) {
        unsigned* bar = b.bar;
        __builtin_amdgcn_s_waitcnt(0);
        unsigned nloc = b.st[0], nx = b.st[1];
        if (nloc == 0u) { xcd_barrier_complete(bar, b.x, nloc, nx); b.st[0] = nloc; b.st[1] = nx; }
        const unsigned old = xb_add(&bar[XB_XSUB(b.x)], 1u);
        const unsigned gen = old / nloc;
        if (old + 1u == (gen + 1u) * nloc) {
            __builtin_amdgcn_fence(__ATOMIC_RELEASE, "agent");
            asm volatile("s_waitcnt vmcnt(0)" ::: "memory");
            const unsigned og = xb_add(&bar[XB_TOP], 1u);
            const unsigned tg = og / nx;
            if (og + 1u == (tg + 1u) * nx) xb_add(&bar[XB_TOPGEN], 1u);
            else XB_SPIN(xb_ld(&bar[XB_TOPGEN]) == tg, bar);
            __builtin_amdgcn_fence(__ATOMIC_ACQUIRE, "agent");
            xb_add(&bar[XB_XGEN(b.x)], 1u);
            asm volatile("s_waitcnt vmcnt(0)" ::: "memory");
        } else {
            XB_SPIN(xb_ld(&bar[XB_XGEN(b.x)]) == gen, bar);
            __builtin_amdgcn_fence(__ATOMIC_ACQUIRE, "agent");
            asm volatile("s_waitcnt vmcnt(0)" ::: "memory");
        }
    }
    __syncthreads();
}
constexpr int NWAVES = 8;
constexpr int BATCH = 8, SEQ = 2048, D = 1024, M = BATCH * SEQ;
constexpr int FOX_W = 512, DIL_W = 768, DIL_OUT_W = 256, D_FF = 2816, IN_COLS = 5896, N_IN = 5888, N_GU = 5632, C_FA = 1536;
constexpr float EPS = 1e-6f, LOG2E = 1.4426950408889634f, C2 = 0.125f * 1.4426950408889634f;
constexpr int MOD_SH_M = 0, MOD_SC_M = 1024, MOD_GA_M = 2048, MOD_SH_F = 3072, MOD_SC_F = 4096, MOD_GA_F = 5120;

constexpr size_t MiB = 1u << 20;
constexpr size_t WS_CTL = 0, CTL_ZERO_BYTES = 64 * 1024;
constexpr size_t WS_MOD = 1 * MiB;
constexpr size_t WS_ROPE = WS_MOD + 256 * 1024;
constexpr size_t WS_LF = WS_MOD + 512 * 1024;
constexpr size_t WS_FC = 2 * MiB;
constexpr size_t WS_WIN = 3 * MiB;
constexpr size_t WS_WBRA = 15 * MiB;
constexpr size_t WS_WBRB = 16 * MiB;
constexpr size_t WS_WOUT = 17 * MiB;
constexpr size_t WS_WGU = 19 * MiB;
constexpr size_t WS_WDN = 30 * MiB;
constexpr size_t WS_XN = 36 * MiB;
constexpr size_t WS_YA = 36 * MiB, WS_YB = 52 * MiB, WS_H2 = 36 * MiB;
constexpr size_t WS_FOX = 68 * MiB;
constexpr size_t WS_DIL = 116 * MiB;
constexpr size_t WS_GATE = 188 * MiB;
constexpr size_t WS_END = 252 * MiB;
constexpr size_t WS_MERGED = WS_FOX;
constexpr size_t WS_ACT = WS_FOX;
constexpr int CW_BAR = 4096;

constexpr int RING_OFF = 0, RING_BYTES = 131072;
constexpr int LDSCTL_OFF = RING_BYTES, MISC_OFF = LDSCTL_OFF + 320;
constexpr int LDS_BYTES = 147456;

struct Frame {
    LAS unsigned char* lds;
    volatile LAS unsigned* MISC;
    gu32* ctl;
    int tid, lane, wave, vcu, G;
};
__device__ __forceinline__ float wave_sum(float v) {
#pragma unroll
    for (int o = 1; o < 64; o <<= 1) v += __shfl_xor(v, o);
    return v;
}
__device__ __forceinline__ float bf2f(unsigned short h) { return __uint_as_float(((unsigned)h) << 16); }
__device__ __forceinline__ float fast_sigmoid(float x) { return __builtin_amdgcn_rcpf(1.f + __builtin_amdgcn_exp2f(-LOG2E * x)); }

namespace pg8 {
struct EpiInProj {
    static constexpr bool PERM = true, AFTER_DRAIN = false;
    bf16_t* fox; bf16_t* dil; bf16_t* gate; const float* rope;
    __device__ __forceinline__ void operator()(const f32x4 (&acc)[2][2][4][2], const Unit& u, int wr, int wc, int fr, int fq) const {
        const int pn = u.pn; bf16_t* base; int ldc, colt; float sc = 1.f; bool rope_on = false;
        if (pn < 6) { const int s = pn >> 1; base = fox + (size_t)s * M * FOX_W; ldc = FOX_W; colt = (pn & 1) * 256; if (s == 0) sc = C2; }
        else if (pn < 15) { const int q = pn - 6, s = q / 3; base = dil + (size_t)s * M * DIL_W; ldc = DIL_W; colt = (q - 3 * s) * 256; if (s == 0) sc = C2; rope_on = (s < 2) && ((wc & 1) == 0); }
        else { const int q = pn - 15, s = q >> 2; base = gate + (size_t)s * M * D; ldc = D; colt = (q & 3) * 256; }
        const int row0 = u.pm * BM + wr * 64 + fr, col0 = colt + wc * 32 + 8 * fq;
#pragma unroll
        for (int ai = 0; ai < 2; ++ai)
#pragma unroll
            for (int m = 0; m < 4; ++m) {
                const int row = row0 + ai * HALF + m * 16; bf16_t* rowp = base + (size_t)row * ldc + col0;
                f32x4 c0, s0, c1, s1;
                if (rope_on) { const f32x4* tp = (const f32x4*)(rope + (size_t)(row & (SEQ - 1)) * 16); const f32x4 t0 = tp[0], t1 = tp[1], t2 = tp[2], t3 = tp[3];
                    c0 = (f32x4){t0[0], t0[2], t1[0], t1[2]}; s0 = (f32x4){t0[1], t0[3], t1[1], t1[3]}; c1 = (f32x4){t2[0], t2[2], t3[0], t3[2]}; s1 = (f32x4){t2[1], t2[3], t3[1], t3[3]}; }
#pragma unroll
                for (int bj = 0; bj < 2; ++bj) {
                    f32x4 v0 = acc[ai][bj][m][0], v1 = acc[ai][bj][m][1];
                    if (rope_on) {
                        f32x4 o0, o1;
#pragma unroll
                        for (int i = 0; i < 4; ++i) { o0[i] = __shfl_xor(v0[i], 16); o1[i] = __shfl_xor(v1[i], 16); }
                        const float sg = (fq == 0) ? -1.f : 1.f;
                        if (fq < 2) { v0 = v0 * c0 + (o0 * s0) * sg; v1 = v1 * c1 + (o1 * s1) * sg; }
                    }
                    v0 = v0 * sc; v1 = v1 * sc;
                    u32x4 w; w.x = cvt_pk_bf16(v0[0], v0[1]); w.y = cvt_pk_bf16(v0[2], v0[3]); w.z = cvt_pk_bf16(v1[0], v1[1]); w.w = cvt_pk_bf16(v1[2], v1[3]);
                    *(u32x4*)(rowp + bj * HALF) = w;
                }
            }
    }
};
struct EpiGateA {
    static constexpr bool PERM = true, AFTER_DRAIN = false;
    float* T; const bf16_t* ga;
    __device__ __forceinline__ void operator()(const f32x4 (&acc)[2][2][4][2], const Unit& u, int wr, int wc, int fr, int fq) const {
        const int row0 = u.pm * BM + wr * 64 + fr, col0 = u.pn * BM + wc * 32 + 8 * fq;
#pragma unroll
        for (int ai = 0; ai < 2; ++ai)
#pragma unroll
            for (int m = 0; m < 4; ++m)
#pragma unroll
                for (int bj = 0; bj < 2; ++bj) {
                    const size_t off = (size_t)(row0 + ai * HALF + m * 16) * D + col0 + bj * HALF;
                    const u32x4 g = *(const u32x4*)(ga + off);
                    f32x4 v0 = acc[ai][bj][m][0], v1 = acc[ai][bj][m][1];
                    v0[0] *= fast_sigmoid(__uint_as_float(g.x << 16)); v0[1] *= fast_sigmoid(__uint_as_float(g.x & 0xffff0000u));
                    v0[2] *= fast_sigmoid(__uint_as_float(g.y << 16)); v0[3] *= fast_sigmoid(__uint_as_float(g.y & 0xffff0000u));
                    v1[0] *= fast_sigmoid(__uint_as_float(g.z << 16)); v1[1] *= fast_sigmoid(__uint_as_float(g.z & 0xffff0000u));
                    v1[2] *= fast_sigmoid(__uint_as_float(g.w << 16)); v1[3] *= fast_sigmoid(__uint_as_float(g.w & 0xffff0000u));
                    *(f32x4*)(T + off) = v0; *(f32x4*)(T + off + 4) = v1;
                }
    }
};
struct EpiGateB {
    static constexpr bool PERM = true, AFTER_DRAIN = false;
    const float* T; const bf16_t* gb; bf16_t* O;
    __device__ __forceinline__ void operator()(const f32x4 (&acc)[2][2][4][2], const Unit& u, int wr, int wc, int fr, int fq) const {
        const int row0 = u.pm * BM + wr * 64 + fr, col0 = u.pn * BM + wc * 32 + 8 * fq;
#pragma unroll
        for (int ai = 0; ai < 2; ++ai)
#pragma unroll
            for (int m = 0; m < 4; ++m)
#pragma unroll
                for (int bj = 0; bj < 2; ++bj) {
                    const size_t off = (size_t)(row0 + ai * HALF + m * 16) * D + col0 + bj * HALF;
                    const u32x4 g = *(const u32x4*)(gb + off);
                    const f32x4 t0 = *(const f32x4*)(T + off), t1 = *(const f32x4*)(T + off + 4);
                    f32x4 v0 = acc[ai][bj][m][0], v1 = acc[ai][bj][m][1];
                    v0[0] = t0[0] + v0[0] * fast_sigmoid(__uint_as_float(g.x << 16)); v0[1] = t0[1] + v0[1] * fast_sigmoid(__uint_as_float(g.x & 0xffff0000u));
                    v0[2] = t0[2] + v0[2] * fast_sigmoid(__uint_as_float(g.y << 16)); v0[3] = t0[3] + v0[3] * fast_sigmoid(__uint_as_float(g.y & 0xffff0000u));
                    v1[0] = t1[0] + v1[0] * fast_sigmoid(__uint_as_float(g.z << 16)); v1[1] = t1[1] + v1[1] * fast_sigmoid(__uint_as_float(g.z & 0xffff0000u));
                    v1[2] = t1[2] + v1[2] * fast_sigmoid(__uint_as_float(g.w << 16)); v1[3] = t1[3] + v1[3] * fast_sigmoid(__uint_as_float(g.w & 0xffff0000u));
                    u32x4 w; w.x = cvt_pk_bf16(v0[0], v0[1]); w.y = cvt_pk_bf16(v0[2], v0[3]); w.z = cvt_pk_bf16(v1[0], v1[1]); w.w = cvt_pk_bf16(v1[2], v1[3]);
                    *(u32x4*)(O + off) = w;
                }
    }
};
struct EpiResid {
    static constexpr bool PERM = false, AFTER_DRAIN = false;
    const float* base; float* out; const float* gate;
    __device__ __forceinline__ void operator()(const f32x4 (&acc)[2][2][4][2], const Unit& u, int wr, int wc, int fr, int fq) const {
        const int row0 = u.pm * BM + wr * 64 + fr, col0 = u.pn * BM + wc * 32 + 4 * fq;
        const float* gp = gate + (size_t)(u.pm / (SEQ / BM)) * 6144;
#pragma unroll
        for (int bj = 0; bj < 2; ++bj)
#pragma unroll
            for (int n = 0; n < 2; ++n) {
                const int col = col0 + bj * HALF + n * 16; const f32x4 gv = *(const f32x4*)(gp + col);
#pragma unroll
                for (int ai = 0; ai < 2; ++ai)
#pragma unroll
                    for (int m = 0; m < 4; ++m) { const size_t off = (size_t)(row0 + ai * HALF + m * 16) * D + col;
                        const f32x4 bs = *(const f32x4*)(base + off); *(f32x4*)(out + off) = bs + gv * acc[ai][bj][m][n]; }
            }
    }
};
struct EpiSwiglu {
    static constexpr bool PERM = true, AFTER_DRAIN = false;
    bf16_t* O;
    __device__ __forceinline__ void operator()(const f32x4 (&acc)[2][2][4][2], const Unit& u, int wr, int wc, int fr, int fq) const {
        const int row0 = u.pm * BM + wr * 64 + fr, col0 = u.pn * HALF + wc * 32 + 8 * fq;
#pragma unroll
        for (int ai = 0; ai < 2; ++ai)
#pragma unroll
            for (int m = 0; m < 4; ++m) {
                f32x4 a0 = acc[ai][0][m][0], a1 = acc[ai][0][m][1]; const f32x4 u0 = acc[ai][1][m][0], u1 = acc[ai][1][m][1];
#pragma unroll
                for (int i = 0; i < 4; ++i) { a0[i] = a0[i] * fast_sigmoid(a0[i]) * u0[i]; a1[i] = a1[i] * fast_sigmoid(a1[i]) * u1[i]; }
                u32x4 w; w.x = cvt_pk_bf16(a0[0], a0[1]); w.y = cvt_pk_bf16(a0[2], a0[3]); w.z = cvt_pk_bf16(a1[0], a1[1]); w.w = cvt_pk_bf16(a1[2], a1[3]);
                *(u32x4*)(O + (size_t)(row0 + ai * HALF + m * 16) * D_FF + col0) = w;
            }
    }
};
}

__device__ __forceinline__ void tr_item(const float* W, int ldw, int k0, int n0s, bf16* WT, int K, int drow0, LAS float* scr, int lane) {
#pragma unroll 8
    for (int i = 0; i < 32; ++i) { const int kk = 2 * i + (lane >> 5); scr[kk * 33 + (lane & 31)] = W[(size_t)(k0 + kk) * ldw + n0s + (lane & 31)]; }
    LDS_WAIT(); asm volatile("" ::: "memory");
    const int c = lane & 7;
#pragma unroll
    for (int j = 0; j < 4; ++j) { const int n = (lane >> 3) + 8 * j; const LAS float* s = scr + (8 * c) * 33 + n;
        v4u o; o.x = pk2(s[0 * 33], s[1 * 33]); o.y = pk2(s[2 * 33], s[3 * 33]); o.z = pk2(s[4 * 33], s[5 * 33]); o.w = pk2(s[6 * 33], s[7 * 33]);
        *(GAS v4u*)(WT + (size_t)(drow0 + n) * K + k0 + 8 * c) = o; }
    LDS_WAIT(); asm volatile("" ::: "memory");
}
struct Ptrs {
    const float *x, *c, *w_ada, *b_ada, *g_mix, *w_in, *b_fgate, *w_br_a, *w_br_b, *w_out, *g_ffn, *w_gate, *w_up, *w_down, *g_final;
    float* out; unsigned char* ws;
};
__device__ __forceinline__ void p0_prologue(Frame& F, const Ptrs& P) {
    unsigned char* ws = P.ws;
    { LAS float* red = (LAS float*)(F.lds + RING_OFF); float* mod = (float*)(ws + WS_MOD);
      for (int ch = F.vcu; ch < 256; ch += F.G) {
          const int col = F.tid % 24, sl = F.tid / 24;
          if (F.tid < 504) { float acc[8];
#pragma unroll
              for (int b = 0; b < 8; ++b) acc[b] = 0.f;
              for (int d = sl; d < D; d += 21) { const float wv = P.w_ada[(size_t)d * 6144 + ch * 24 + col];
#pragma unroll
                  for (int b = 0; b < 8; ++b) { const float cv = P.c[b * D + d]; acc[b] += cv * fast_sigmoid(cv) * wv; } }
#pragma unroll
              for (int b = 0; b < 8; ++b) red[(sl * 8 + b) * 24 + col] = acc[b]; }
          __syncthreads();
          if (F.tid < 192) { const int b = F.tid / 24, c2 = F.tid % 24; float s = 0.f;
              for (int q = 0; q < 21; ++q) s += red[(q * 8 + b) * 24 + c2];
              mod[b * 6144 + ch * 24 + c2] = s + P.b_ada[ch * 24 + c2]; }
          __syncthreads();
      } }
    { const int i = F.vcu * (NWAVES * 64) + F.tid;
      if (i < SEQ * 8) { const int pos = i >> 3, j = i & 7;
          float inv_freq = 1.0f;
          inv_freq = (j == 1) ? 0.19392274474868576f : inv_freq; inv_freq = (j == 2) ? 0.03760603093086393f : inv_freq; inv_freq = (j == 3) ? 0.007292664737217109f : inv_freq;
          inv_freq = (j == 4) ? 0.001414213562373095f : inv_freq; inv_freq = (j == 5) ? 0.0002742481756762073f : inv_freq; inv_freq = (j == 6) ? 5.318295896944988e-05f : inv_freq;
          inv_freq = (j == 7) ? 1.031338537721246e-05f : inv_freq;
          const float ang = (float)pos * inv_freq; const double a = (double)ang; const double k = rint(a * 0.15915494309189535); const float r = (float)(a - k * 6.283185307179586);
          float* tab = (float*)(ws + WS_ROPE); tab[i * 2] = __cosf(r); tab[i * 2 + 1] = __sinf(r); } }
    LAS float* scr = (LAS float*)(F.lds + RING_OFF + F.wave * 16384);
    const int gw = F.vcu * NWAVES + F.wave, NGW = F.G * NWAVES;
    constexpr int I_IN = 16 * 184, I_A = 8 * 32, I_B = 4 * 32, I_O = 16 * 32, I_G = 16 * 88, I_D = 44 * 32;
    constexpr int NITEMS = I_IN + I_A + I_B + I_O + 2 * I_G + I_D;
    for (int it = gw; it < NITEMS; it += NGW) {
        int r = it;
        if (r < I_IN) { const int kb = r / 184, nb = r % 184, n0 = 32 * nb; tr_item(P.w_in, IN_COLS, 64 * kb, n0 < C_FA ? n0 : n0 + 8, (bf16*)(ws + WS_WIN), D, n0, scr, F.lane); continue; } r -= I_IN;
        if (r < I_A) { const int kb = r / 32, nb = r % 32; tr_item(P.w_br_a, D, 64 * kb, 32 * nb, (bf16*)(ws + WS_WBRA), FOX_W, 32 * nb, scr, F.lane); continue; } r -= I_A;
        if (r < I_B) { const int kb = r / 32, nb = r % 32; tr_item(P.w_br_b, D, 64 * kb, 32 * nb, (bf16*)(ws + WS_WBRB), DIL_OUT_W, 32 * nb, scr, F.lane); continue; } r -= I_B;
        if (r < I_O) { const int kb = r / 32, nb = r % 32; tr_item(P.w_out, D, 64 * kb, 32 * nb, (bf16*)(ws + WS_WOUT), D, 32 * nb, scr, F.lane); continue; } r -= I_O;
        if (r < 2 * I_G) { const int up = r >= I_G ? 1 : 0; r -= up * I_G; const int kb = r / 88, nb = r % 88, n0 = 32 * nb;
            tr_item(up ? P.w_up : P.w_gate, D_FF, 64 * kb, n0, (bf16*)(ws + WS_WGU), D, 256 * (n0 >> 7) + (n0 & 127) + 128 * up, scr, F.lane); continue; } r -= 2 * I_G;
        { const int kb = r / 32, nb = r % 32; tr_item(P.w_down, D, 64 * kb, 32 * nb, (bf16*)(ws + WS_WDN), D_FF, 32 * nb, scr, F.lane); }
    }
}
template <bool WITH_FA>
__device__ __forceinline__ void norm_mod_rows(Frame& F, const float* x, const float* g, const float* mod, int sh_off, int sc_off, bf16* outp, const LAS float* wfa, const float* b_fgate, float* lf) {
    const int gw = F.vcu * NWAVES + F.wave, NGW = F.G * NWAVES;
    for (int m = gw; m < M; m += NGW) {
        const int b = m / SEQ;
        const GAS f32x4* xr = (const GAS f32x4*)(x + (size_t)m * D) + F.lane;
        f32x4 v[4]; float s2 = 0.f;
#pragma unroll
        for (int j = 0; j < 4; ++j) { v[j] = xr[64 * j]; s2 += (v[j].x * v[j].x + v[j].y * v[j].y) + (v[j].z * v[j].z + v[j].w * v[j].w); }
        const float rstd = 1.f / sqrtf(wave_sum(s2) * (1.f / D) + EPS);
        const f32x4* gp = (const f32x4*)g + F.lane; const f32x4* scp = (const f32x4*)(mod + b * 6144 + sc_off) + F.lane; const f32x4* shp = (const f32x4*)(mod + b * 6144 + sh_off) + F.lane;
        GAS unsigned long long* o8 = (GAS unsigned long long*)(outp + (size_t)m * D) + F.lane;
        float fa[8];
#pragma unroll
        for (int h = 0; h < 8; ++h) fa[h] = 0.f;
#pragma unroll
        for (int j = 0; j < 4; ++j) {
            const f32x4 gv = gp[64 * j], sc = scp[64 * j], sh = shp[64 * j];
            const f32x4 hv = (v[j] * rstd) * gv * (sc + 1.0f) + sh;
            o8[64 * j] = (unsigned long long)pk2(hv.x, hv.y) | ((unsigned long long)pk2(hv.z, hv.w) << 32);
            if (WITH_FA) {
#pragma unroll
                for (int h = 0; h < 8; ++h) { const f32x4 w = *(const LAS f32x4*)(wfa + h * D + 4 * F.lane + 256 * j); fa[h] += (hv.x * w.x + hv.y * w.y) + (hv.z * w.z + hv.w * w.w); }
            }
        }
        if (WITH_FA) {
#pragma unroll
            for (int h = 0; h < 8; ++h) { const float s = wave_sum(fa[h]) + b_fgate[h]; const float ls = fminf(s, 0.f) - log1pf(__expf(-fabsf(s))); if (F.lane == 0) lf[(size_t)m * 8 + h] = ls; }
        }
    }
}
__device__ __forceinline__ void final_rows(Frame& F, float* x, const float* g) {
    const int gw = F.vcu * NWAVES + F.wave, NGW = F.G * NWAVES;
    for (int m = gw; m < M; m += NGW) {
        GAS f32x4* xr = (GAS f32x4*)(x + (size_t)m * D) + F.lane;
        f32x4 v[4]; float s2 = 0.f;
#pragma unroll
        for (int j = 0; j < 4; ++j) { v[j] = xr[64 * j]; s2 += (v[j].x * v[j].x + v[j].y * v[j].y) + (v[j].z * v[j].z + v[j].w * v[j].w); }
        const float rstd = 1.f / sqrtf(wave_sum(s2) * (1.f / D) + EPS);
        const f32x4* gp = (const f32x4*)g + F.lane;
#pragma unroll
        for (int j = 0; j < 4; ++j) xr[64 * j] = (v[j] * rstd) * gp[64 * j];
    }
}
__device__ __forceinline__ void cumsum_phase(Frame& F, const float* lf, float* fc) {
    for (int bh = blockIdx.x; bh < 64; bh += F.G) {
        const int b = bh >> 3, h = bh & 7, t0 = F.tid * 4;
        float p[4];
#pragma unroll
        for (int i = 0; i < 4; ++i) p[i] = lf[((size_t)(b * SEQ + t0 + i)) * 8 + h];
        p[1] += p[0]; p[2] += p[1]; p[3] += p[2];
        float inc = p[3];
#pragma unroll
        for (int o = 1; o < 64; o <<= 1) { const float n = __shfl_up(inc, o); if (F.lane >= o) inc += n; }
        LAS float* wt = (LAS float*)(F.lds + RING_OFF);
        if (F.lane == 63) wt[F.wave] = inc;
        __syncthreads();
        float off = inc - p[3];
        for (int w = 0; w < F.wave; ++w) off += wt[w];
        *(f32x4*)(fc + (size_t)bh * SEQ + t0) = (f32x4){p[0] + off, p[1] + off, p[2] + off, p[3] + off};
        __syncthreads();
    }
}
__device__ __forceinline__ void fox_naive(Frame& F, const bf16* Q, const bf16* K, const bf16* V, const float* fc, bf16* ya) {
    const int gw = F.vcu * NWAVES + F.wave, NGW = F.G * NWAVES;
    for (int it = gw; it < BATCH * 8 * SEQ; it += NGW) {
        const int bh = it / SEQ, t = (it + (it / SEQ) * 331) % SEQ, b = bh >> 3, h = bh & 7;
        const size_t rowq = (size_t)(b * SEQ + t);
        const float q = bf2f(Q[rowq * FOX_W + h * 64 + F.lane]);
        const float* fcp = fc + (size_t)bh * SEQ; const float Ft = fcp[t] * LOG2E;
        float m = -1e30f, l = 0.f, o = 0.f;
        for (int s = 0; s <= t; ++s) {
            const size_t rs = (size_t)(b * SEQ + s);
            const float kv = bf2f(K[rs * FOX_W + h * 64 + F.lane]), vv = bf2f(V[rs * FOX_W + h * 64 + F.lane]);
            const float logit = wave_sum(q * kv) + (Ft - fcp[s] * LOG2E);
            const float mn = fmaxf(m, logit), a = __builtin_amdgcn_exp2f(m - mn), p = __builtin_amdgcn_exp2f(logit - mn);
            l = l * a + p; o = o * a + p * vv; m = mn;
        }
        ya[rowq * FOX_W + h * 64 + F.lane] = (bf16)pk2(o / l, 0.f);
    }
}
__device__ __forceinline__ void dil_naive(Frame& F, const bf16* Q, const bf16* K, const bf16* V, bf16* yb) {
    const int gw = F.vcu * NWAVES + F.wave, NGW = F.G * NWAVES;
    for (int it = gw; it < BATCH * 4 * SEQ; it += NGW) {
        const int t = it % SEQ, hs = (it / SEQ) & 3, b = it / (SEQ * 4);
        const size_t rowq = (size_t)(b * SEQ + t);
        float og[3], lse[3];
#pragma unroll
        for (int g = 0; g < 3; ++g) {
            const int dl = g == 0 ? 1 : (g == 1 ? 4 : 16), head = g * 4 + hs;
            const float q = bf2f(Q[rowq * DIL_W + head * 64 + F.lane]);
            float m = -1e30f, l = 0.f, o = 0.f;
            for (int j = 0; j <= 128; ++j) {
                const int s = t - j * dl; if (s < 0) break;
                const size_t rs = (size_t)(b * SEQ + s);
                const float kv = bf2f(K[rs * DIL_W + head * 64 + F.lane]), vv = bf2f(V[rs * DIL_W + head * 64 + F.lane]);
                const float logit = wave_sum(q * kv);
                const float mn = fmaxf(m, logit), a = __builtin_amdgcn_exp2f(m - mn), p = __builtin_amdgcn_exp2f(logit - mn);
                l = l * a + p; o = o * a + p * vv; m = mn;
            }
            og[g] = o / l; lse[g] = m + __builtin_amdgcn_logf(l);
        }
        const float mx = fmaxf(lse[0], fmaxf(lse[1], lse[2]));
        const float w0 = __builtin_amdgcn_exp2f(lse[0] - mx), w1 = __builtin_amdgcn_exp2f(lse[1] - mx), w2 = __builtin_amdgcn_exp2f(lse[2] - mx);
        yb[rowq * DIL_OUT_W + hs * 64 + F.lane] = (bf16)pk2((w0 * og[0] + w1 * og[1] + w2 * og[2]) / (w0 + w1 + w2), 0.f);
    }
}

__global__ void __launch_bounds__(NWAVES * 64, 2) mega_fwd(Ptrs P) {
    extern __shared__ __attribute__((aligned(16))) unsigned char lds[];
    Frame F;
    F.lds = (LAS unsigned char*)lds;
    F.MISC = (volatile LAS unsigned*)(F.lds + MISC_OFF);
#define FRESH_TID() do { int t_ = threadIdx.x; asm volatile("" : "+v"(t_)); F.tid = t_; F.lane = t_ & 63; F.wave = __builtin_amdgcn_readfirstlane(t_ >> 6); } while (0)
    FRESH_TID();
    F.G = gridDim.x; { const int bx = blockIdx.x; F.vcu = (F.G % 8 == 0) ? (bx % 8) * (F.G / 8) + bx / 8 : bx; }
    unsigned char* ws = P.ws;
    F.ctl = (gu32*)(ws + WS_CTL);
    for (int u = F.tid; u < (LDS_BYTES - LDSCTL_OFF) / 4; u += NWAVES * 64) ((LAS unsigned*)(F.lds + LDSCTL_OFF))[u] = 0u;
    __syncthreads();
    XcdBarrier bar = xcd_barrier_post((unsigned*)(F.ctl + CW_BAR), F.MISC + 8);
#define GRID_BAR() xcd_barrier(bar)
    float* mod = (float*)(ws + WS_MOD); float* rope = (float*)(ws + WS_ROPE); float* lf = (float*)(ws + WS_LF); float* fc = (float*)(ws + WS_FC);
    bf16* XN = (bf16*)(ws + WS_XN); bf16* YA = (bf16*)(ws + WS_YA); bf16* YB = (bf16*)(ws + WS_YB); bf16* H2 = (bf16*)(ws + WS_H2);
    bf16* FOX = (bf16*)(ws + WS_FOX); bf16* DIL = (bf16*)(ws + WS_DIL); bf16* GATE = (bf16*)(ws + WS_GATE); bf16* MERGED = (bf16*)(ws + WS_MERGED); bf16* ACT = (bf16*)(ws + WS_ACT);

    FRESH_TID(); p0_prologue(F, P);
    GRID_BAR();
    FRESH_TID();
    { LAS float* wfa = (LAS float*)(F.lds + RING_OFF);
      for (int i = F.tid; i < 8 * D; i += NWAVES * 64) { const int h = i >> 10, d = i & (D - 1); wfa[i] = P.w_in[(size_t)d * IN_COLS + C_FA + h]; }
      __syncthreads();
      norm_mod_rows<true>(F, P.x, P.g_mix, mod, MOD_SH_M, MOD_SC_M, XN, wfa, P.b_fgate, lf);
      __syncthreads(); }
    GRID_BAR();
    FRESH_TID(); cumsum_phase(F, lf, fc);
    { pg8::Gemm g{XN, (const bf16*)(ws + WS_WIN), M, N_IN, D}; pg8::StaticOrder S; S.init(M, N_IN, F.G, (int)blockIdx.x);
      pg8::EpiInProj E{FOX, DIL, GATE, rope};
      pg8::gemm_phase<pg8::EpiInProj, pg8::StaticOrder, PG8_ALIGN, PG8_SP2>(F.lds + RING_OFF, g, S, E); }
    GRID_BAR();
    FRESH_TID(); fox_naive(F, FOX, FOX + (size_t)M * FOX_W, FOX + (size_t)2 * M * FOX_W, fc, YA);
    FRESH_TID(); dil_naive(F, DIL, DIL + (size_t)M * DIL_W, DIL + (size_t)2 * M * DIL_W, YB);
    GRID_BAR();
    { pg8::Gemm g{YA, (const bf16*)(ws + WS_WBRA), M, D, FOX_W}; pg8::StaticOrder S; S.init(M, D, F.G, (int)blockIdx.x);
      pg8::EpiGateA E{P.out, GATE};
      pg8::gemm_phase<pg8::EpiGateA, pg8::StaticOrder, false, PG8_SP2>(F.lds + RING_OFF, g, S, E); }
    { pg8::Gemm g{YB, (const bf16*)(ws + WS_WBRB), M, D, DIL_OUT_W}; pg8::StaticOrder S; S.init(M, D, F.G, (int)blockIdx.x);
      pg8::EpiGateB E{P.out, GATE + (size_t)M * D, MERGED};
      pg8::gemm_phase<pg8::EpiGateB, pg8::StaticOrder, false, PG8_SP2>(F.lds + RING_OFF, g, S, E); }
    GRID_BAR();
    { pg8::Gemm g{MERGED, (const bf16*)(ws + WS_WOUT), M, D, D}; pg8::StaticOrder S; S.init(M, D, F.G, (int)blockIdx.x);
      pg8::EpiResid E{P.x, P.out, mod + MOD_GA_M};
      pg8::gemm_phase<pg8::EpiResid, pg8::StaticOrder, false, PG8_SP2>(F.lds + RING_OFF, g, S, E); }
    GRID_BAR();
    FRESH_TID(); norm_mod_rows<false>(F, P.out, P.g_ffn, mod, MOD_SH_F, MOD_SC_F, H2, nullptr, nullptr, nullptr);
    GRID_BAR();
    { pg8::Gemm g{H2, (const bf16*)(ws + WS_WGU), M, N_GU, D}; pg8::StaticOrder S; S.init(M, N_GU, F.G, (int)blockIdx.x);
      pg8::EpiSwiglu E{ACT};
      pg8::gemm_phase<pg8::EpiSwiglu, pg8::StaticOrder, PG8_ALIGN, PG8_SP2>(F.lds + RING_OFF, g, S, E); }
    GRID_BAR();
    { pg8::Gemm g{ACT, (const bf16*)(ws + WS_WDN), M, D, D_FF}; pg8::StaticOrder S; S.init(M, D, F.G, (int)blockIdx.x);
      pg8::EpiResid E{P.out, P.out, mod + MOD_GA_F};
      pg8::gemm_phase<pg8::EpiResid, pg8::StaticOrder, false, PG8_SP2>(F.lds + RING_OFF, g, S, E); }
    GRID_BAR();
    FRESH_TID(); final_rows(F, P.out, P.g_final);
}

extern "C" void kernel_launch(void* const* d_in, const int* in_sizes, int n_in, void* d_out, int out_size, void* d_ws, size_t ws_size, hipStream_t stream) {
    static int grid = 0;
    if (grid == 0) {
        if (n_in != 15 || in_sizes[0] != M * D || out_size != M * D || ws_size < WS_END) { fprintf(stderr, "kernel_launch: unexpected shapes: n_in %d in0 %d out %d ws %zu\n", n_in, n_in > 0 ? in_sizes[0] : -1, out_size, ws_size); grid = -1; return; }
        int dev = 0, cus = 0, per_cu = 0;
        if (hipGetDevice(&dev) != hipSuccess || hipDeviceGetAttribute(&cus, hipDeviceAttributeMultiprocessorCount, dev) != hipSuccess) { grid = -1; return; }
        if (hipFuncSetAttribute((const void*)mega_fwd, hipFuncAttributeMaxDynamicSharedMemorySize, LDS_BYTES) != hipSuccess) { fprintf(stderr, "kernel_launch: hipFuncSetAttribute failed\n"); grid = -1; return; }
        if (hipOccupancyMaxActiveBlocksPerMultiprocessor(&per_cu, (const void*)mega_fwd, NWAVES * 64, LDS_BYTES) != hipSuccess || per_cu < 1) { fprintf(stderr, "kernel_launch: occupancy query says %d blocks per CU\n", per_cu); per_cu = 1; }
        (void)hipGetLastError();
        grid = cus;
        if (grid != 256) fprintf(stderr, "kernel_launch: %d CUs; this build assumes 256\n", grid);
    }
    if (grid < 0) return;
    (void)hipMemsetAsync((char*)d_ws + WS_CTL, 0, CTL_ZERO_BYTES, stream);
    Ptrs p{};
    p.x = (const float*)d_in[0]; p.c = (const float*)d_in[1]; p.w_ada = (const float*)d_in[2]; p.b_ada = (const float*)d_in[3]; p.g_mix = (const float*)d_in[4];
    p.w_in = (const float*)d_in[5]; p.b_fgate = (const float*)d_in[6]; p.w_br_a = (const float*)d_in[7]; p.w_br_b = (const float*)d_in[8]; p.w_out = (const float*)d_in[9];
    p.g_ffn = (const float*)d_in[10]; p.w_gate = (const float*)d_in[11]; p.w_up = (const float*)d_in[12]; p.w_down = (const float*)d_in[13]; p.g_final = (const float*)d_in[14];
    p.out = (float*)d_out; p.ws = (unsigned char*)d_ws;
    hipLaunchKernelGGL(mega_fwd, dim3(grid), dim3(NWAVES * 64), LDS_BYTES, stream, p);
}
```

```cpp
#include <hip/hip_runtime.h>
#include <cstdio>
#include <cstdint>
namespace pg8 {
#define PG8_LAS __attribute__((address_space(3)))
typedef unsigned short bf16_t;
typedef short bf16x8 __attribute__((ext_vector_type(8)));
typedef float f32x4 __attribute__((ext_vector_type(4)));
typedef unsigned u32x4 __attribute__((ext_vector_type(4)));
constexpr int BM = 256, BK = 64, HALF = 128, HTB = HALF * BK * 2  , STAGE_BYTES = 8 * HTB, NXCD = 8, WGM = 8;

__host__ __device__ __forceinline__ int lds_byte(int r, int c) { const int st = (r >> 4) * 2 + (c >> 5), rr = r & 15, cc = c & 31, ob = rr * 64 + cc * 2; return st * 1024 + (ob ^ (((ob >> 9) & 1) << 5)); }
__host__ __device__ __forceinline__ void stage_rc(int b, int& R, int& C) { const int st = b / 1024, sb = b % 1024, swz = sb ^ (((sb >> 9) & 1) << 5); R = (st >> 1) * 16 + swz / 64; C = (st & 1) * 32 + (swz % 64) / 2; }
__host__ __device__ __forceinline__ int perm32(int rho) { const int n = rho >> 4, i = rho & 15; return 8 * (i >> 2) + 4 * n + (i & 3); }

struct Unit { int pm, pn; };
struct Gemm { const bf16_t* A; const bf16_t* Bt; int M, N, K; };

struct StaticOrder {
    int nM, nN, nwg, G, c;
    __host__ __device__ void init(int M, int N, int G_, int c_) { nM = M / BM; nN = N / BM; nwg = nM * nN; G = G_; c = c_; }
    __host__ __device__ bool next(int i, Unit& u) const {
        const long L = (long)i * G + c; if (L >= nwg) return false;
        int wgid = (int)L; { const int q = nwg / NXCD, r = nwg % NXCD, xcd = wgid % NXCD, off = wgid / NXCD; wgid = (xcd < r ? xcd * (q + 1) : r * (q + 1) + (xcd - r) * q) + off; }
        const int nig = WGM * nN, gid = wgid / nig, fm = gid * WGM, gsz = (nM - fm) < WGM ? (nM - fm) : WGM;
        u.pm = fm + ((wgid % nig) % gsz); u.pn = (wgid % nig) / gsz; return true;
    }
    __device__ __forceinline__ void a_ready(const Unit&) const {}
    __device__ __forceinline__ void done(const Unit&) const {}
};

__device__ __forceinline__ unsigned cvt_pk_bf16(float lo, float hi) { unsigned r; asm volatile("v_cvt_pk_bf16_f32 %0, %1, %2" : "=v"(r) : "v"(lo), "v"(hi)); return r; }
typedef float f32x2 __attribute__((ext_vector_type(2)));
__device__ __forceinline__ f32x2 gelu_pk(f32x2 v) {
    const f32x2 av = __builtin_elementwise_abs(v), d = av * 0.2316418882f + 1.0f;
    f32x2 t; t.x = __builtin_amdgcn_rcpf(d.x); t.y = __builtin_amdgcn_rcpf(d.y);
    f32x2 q = t * 0.5307027145f + (-0.7265760135f); q = q * t + 0.7107068705f; q = q * t + (-0.142248368f); q = q * t + 0.127414796f; q = q * t;
    const f32x2 s = (v * v) * (-0.72134752044f);
    f32x2 e; e.x = __builtin_amdgcn_exp2f(s.x); e.y = __builtin_amdgcn_exp2f(s.y);
    const f32x2 m = v * (q * e), r = v - m;
    f32x2 o; o.x = v.x < 0.f ? m.x : r.x; o.y = v.y < 0.f ? m.y : r.y; return o;
}

template <int ACT  > struct EpiBf16 {
    static constexpr bool PERM = true, AFTER_DRAIN = false; static_assert(ACT == 0 || ACT == 1, "EpiBf16: ACT is 0 (none) or 1 (gelu_pk)");
    bf16_t* O; int ldc; const float* bias; int split_cols; size_t split_stride; float scale0;
    __device__ __forceinline__ void operator()(const f32x4 (&acc)[2][2][4][2], const Unit& u, int wr, int wc, int fr, int fq) const {
        const int row0 = u.pm * BM + wr * 64 + fr; int colt = u.pn * BM; bf16_t* base = O;
        float sc = 1.f; if (split_cols) { const int t = colt / split_cols; base += (size_t)t * split_stride; colt -= t * split_cols; if (t == 0) sc = scale0; }
        const int col0 = colt + wc * 32 + 8 * fq, bcol0 = u.pn * BM + wc * 32 + 8 * fq;
        f32x4 bv[2][2];
#pragma unroll
        for (int bj = 0; bj < 2; ++bj)
#pragma unroll
            for (int n = 0; n < 2; ++n) bv[bj][n] = bias ? *(const f32x4*)(bias + bcol0 + bj * HALF + 4 * n) : (f32x4){0.f, 0.f, 0.f, 0.f};
#pragma unroll
        for (int ai = 0; ai < 2; ++ai)
#pragma unroll
            for (int m = 0; m < 4; ++m) { bf16_t* rowp = base + (size_t)(row0 + ai * HALF + m * 16) * ldc + col0;
#pragma unroll
                for (int bj = 0; bj < 2; ++bj) { f32x4 v0 = acc[ai][bj][m][0] + bv[bj][0], v1 = acc[ai][bj][m][1] + bv[bj][1];
                    if (ACT == 1) { f32x2 a = gelu_pk((f32x2){v0[0], v0[1]}), b = gelu_pk((f32x2){v0[2], v0[3]}), c = gelu_pk((f32x2){v1[0], v1[1]}), d = gelu_pk((f32x2){v1[2], v1[3]});
                        v0 = (f32x4){a.x, a.y, b.x, b.y}; v1 = (f32x4){c.x, c.y, d.x, d.y}; }
                    v0 = v0 * sc; v1 = v1 * sc; u32x4 w; w.x = cvt_pk_bf16(v0[0], v0[1]); w.y = cvt_pk_bf16(v0[2], v0[3]); w.z = cvt_pk_bf16(v1[0], v1[1]); w.w = cvt_pk_bf16(v1[2], v1[3]);
                    *(u32x4*)(rowp + bj * HALF) = w; } }
    }
};
template <class Epi, class Sched, bool ALIGN_EPI = false, bool SP2 = false>
__device__ __forceinline__ void gemm_phase(PG8_LAS unsigned char* lds, const Gemm g, const Sched& S, const Epi& E) {
    int tid_ = threadIdx.x; asm volatile("" : "+v"(tid_));
    const int tid = tid_, wid = __builtin_amdgcn_readfirstlane(tid >> 6), lane = tid & 63, wr = wid >> 2, wc = wid & 3, fr = lane & 15, fq = lane >> 4;
    const int K = g.K, nt = K / BK;
    unsigned voffA[2], voffB[2];
#pragma unroll
    for (int i = 0; i < 2; ++i) { int R, C; stage_rc(tid * 16 + i * 8192, R, C); const int Rb = Epi::PERM ? ((R & ~31) + perm32(R & 31)) : R;
        voffA[i] = (unsigned)(R * K + C) * 2u; voffB[i] = (unsigned)(Rb * K + C) * 2u; }
    const size_t kstep = (size_t)(BK * 2);
    const size_t hstep = (size_t)HALF * K * 2;
    const size_t tstep = 2 * hstep;
    const unsigned ldsw = (unsigned)wid * 1024u;
    const int aoff = lds_byte(wr * 64 + fr, fq * 8), boff = lds_byte(wc * 32 + fr, fq * 8);
#define PG8_SA(b, h) (((b) * 2 + (h)) * HTB)
#define PG8_SB(b, h) ((4 + (b) * 2 + (h)) * HTB)
#define PG8_STAGE(bufoff, gbase, voff) do { _Pragma("unroll") for (int _i = 0; _i < 2; ++_i) \
        __builtin_amdgcn_global_load_lds((const unsigned*)((const char*)(gbase) + (voff)[_i]), (PG8_LAS unsigned*)(lds + (bufoff) + ldsw + _i * 8192), 16, 0, 0); } while (0)
#define PG8_LDA(dst, b, h) do { _Pragma("unroll") for (int m = 0; m < 4; ++m) _Pragma("unroll") for (int k = 0; k < 2; ++k) dst[m][k] = *(const PG8_LAS bf16x8*)(lds + PG8_SA(b, h) + aoff + m * 2048 + k * 1024); } while (0)
#define PG8_LDB(dst, b, h) do { _Pragma("unroll") for (int n = 0; n < 2; ++n) _Pragma("unroll") for (int k = 0; k < 2; ++k) dst[n][k] = *(const PG8_LAS bf16x8*)(lds + PG8_SB(b, h) + boff + n * 2048 + k * 1024); } while (0)
#define PG8_MMA(ai, bj, At, Bt) do { __builtin_amdgcn_s_setprio(1); _Pragma("unroll") for (int m = 0; m < 4; ++m) _Pragma("unroll") for (int n = 0; n < 2; ++n) _Pragma("unroll") for (int k = 0; k < 2; ++k) \
        acc[ai][bj][m][n] = __builtin_amdgcn_mfma_f32_16x16x32_bf16(Bt[n][k], At[m][k], acc[ai][bj][m][n], 0, 0, 0); __builtin_amdgcn_s_setprio(0); } while (0)
#define PG8_WAIT_V(n) asm volatile("s_waitcnt vmcnt(" #n ")" ::: "memory")
#define PG8_WAIT_L(n) asm volatile("s_waitcnt lgkmcnt(" #n ")" ::: "memory")
#define PG8_BAR __builtin_amdgcn_s_barrier()
#define PG8_SCHED __builtin_amdgcn_sched_barrier(0)
    Unit cur, nxt; int ui = 0;
    if (!S.next(0, cur)) return;
    f32x4 acc[2][2][4][2];
#pragma unroll
    for (int a = 0; a < 2; ++a)
#pragma unroll
        for (int b = 0; b < 2; ++b)
#pragma unroll
            for (int m = 0; m < 4; ++m)
#pragma unroll
                for (int n = 0; n < 2; ++n) acc[a][b][m][n] = (f32x4){0.f, 0.f, 0.f, 0.f};
    bf16x8 At[4][2], B0[2][2], B1[2][2];
    const char* cA = (const char*)g.A + (size_t)cur.pm * tstep; const char* cB = (const char*)g.Bt + (size_t)cur.pn * tstep;
    S.a_ready(cur);
    if constexpr (SP2) {
        PG8_STAGE(PG8_SB(0, 0), cB, voffB); PG8_STAGE(PG8_SB(0, 1), cB + hstep, voffB); PG8_STAGE(PG8_SA(0, 0), cA, voffA); PG8_STAGE(PG8_SA(0, 1), cA + hstep, voffA);
        if (wr == 1) PG8_BAR;
        PG8_WAIT_V(2); PG8_BAR;
        PG8_STAGE(PG8_SB(1, 0), cB + kstep, voffB); PG8_STAGE(PG8_SA(1, 0), cA + kstep, voffA); PG8_STAGE(PG8_SB(1, 1), cB + hstep + kstep, voffB);
        PG8_WAIT_V(6); PG8_BAR;
    } else {
        PG8_STAGE(PG8_SB(0, 0), cB, voffB); PG8_STAGE(PG8_SA(0, 0), cA, voffA); PG8_STAGE(PG8_SB(0, 1), cB + hstep, voffB); PG8_STAGE(PG8_SA(0, 1), cA + hstep, voffA);
        if (wr == 1) PG8_BAR;
        PG8_WAIT_V(4); PG8_BAR;
        PG8_STAGE(PG8_SB(1, 0), cB + kstep, voffB); PG8_STAGE(PG8_SA(1, 0), cA + kstep, voffA); PG8_STAGE(PG8_SB(1, 1), cB + hstep + kstep, voffB);
        PG8_WAIT_V(6); PG8_BAR;
    }
    for (;;) {
        const bool has_next = S.next(ui + 1, nxt);
        const char* nA = has_next ? (const char*)g.A + (size_t)nxt.pm * tstep : cA; const char* nB = has_next ? (const char*)g.Bt + (size_t)nxt.pn * tstep : cB;
        for (int t = 0; t < nt; t += 2) {
            const bool last = (t == nt - 2);
            const char* a1 = cA + (size_t)(t + 1) * kstep;
            const char* a2 = last ? nA : cA + (size_t)(t + 2) * kstep; const char* b2 = last ? nB : cB + (size_t)(t + 2) * kstep;
            const char* a3 = a2 + kstep; const char* b3 = b2 + kstep;
            if (last && has_next) S.a_ready(nxt);
            if constexpr (SP2) {
            PG8_LDB(B0, 0, 0); PG8_LDB(B1, 0, 1); PG8_SCHED; PG8_LDA(At, 0, 0); PG8_STAGE(PG8_SA(1, 1), a1 + hstep, voffA);
            PG8_WAIT_V(8); PG8_WAIT_L(0); PG8_BAR; PG8_MMA(0, 0, At, B0); PG8_MMA(0, 1, At, B1); PG8_BAR; PG8_SCHED;
            PG8_LDA(At, 0, 1); PG8_STAGE(PG8_SB(0, 0), b2, voffB); PG8_STAGE(PG8_SB(0, 1), b2 + hstep, voffB); PG8_STAGE(PG8_SA(0, 0), a2, voffA);
            PG8_WAIT_V(8); PG8_WAIT_L(0); PG8_BAR; PG8_MMA(1, 0, At, B0); PG8_MMA(1, 1, At, B1); PG8_BAR; PG8_SCHED;
            PG8_LDB(B0, 1, 0); PG8_LDB(B1, 1, 1); PG8_SCHED; PG8_LDA(At, 1, 0); PG8_STAGE(PG8_SA(0, 1), a2 + hstep, voffA);
            PG8_WAIT_V(8); PG8_WAIT_L(0); PG8_BAR; PG8_MMA(0, 0, At, B0); PG8_MMA(0, 1, At, B1); PG8_BAR; PG8_SCHED;
            PG8_LDA(At, 1, 1); PG8_STAGE(PG8_SB(1, 0), b3, voffB); PG8_STAGE(PG8_SB(1, 1), b3 + hstep, voffB); PG8_STAGE(PG8_SA(1, 0), a3, voffA);
            PG8_WAIT_V(8); PG8_WAIT_L(0); PG8_BAR; PG8_MMA(1, 0, At, B0); PG8_MMA(1, 1, At, B1); PG8_BAR; PG8_SCHED;
            } else {
            PG8_LDB(B0, 0, 0); PG8_SCHED; PG8_LDA(At, 0, 0); PG8_STAGE(PG8_SA(1, 1), a1 + hstep, voffA);
            PG8_WAIT_L(8); PG8_BAR; PG8_WAIT_L(0); PG8_MMA(0, 0, At, B0); PG8_BAR; PG8_SCHED;
            PG8_LDB(B1, 0, 1); PG8_STAGE(PG8_SB(0, 0), b2, voffB);
            PG8_BAR; PG8_WAIT_L(0); PG8_MMA(0, 1, At, B1); PG8_BAR;
            PG8_LDA(At, 0, 1); PG8_STAGE(PG8_SA(0, 0), a2, voffA);
            PG8_BAR; PG8_WAIT_L(0); PG8_MMA(1, 0, At, B0); PG8_BAR; PG8_SCHED;
            PG8_STAGE(PG8_SB(0, 1), b2 + hstep, voffB);
            PG8_WAIT_V(6); PG8_BAR; PG8_MMA(1, 1, At, B1); PG8_BAR;
            PG8_LDB(B0, 1, 0); PG8_SCHED; PG8_LDA(At, 1, 0); PG8_STAGE(PG8_SA(0, 1), a2 + hstep, voffA);
            PG8_WAIT_L(8); PG8_BAR; PG8_WAIT_L(0); PG8_MMA(0, 0, At, B0); PG8_BAR; PG8_SCHED;
            PG8_LDB(B1, 1, 1); PG8_STAGE(PG8_SB(1, 0), b3, voffB);
            PG8_BAR; PG8_WAIT_L(0); PG8_MMA(0, 1, At, B1); PG8_BAR;
            PG8_LDA(At, 1, 1); PG8_STAGE(PG8_SA(1, 0), a3, voffA);
            PG8_BAR; PG8_WAIT_L(0); PG8_MMA(1, 0, At, B0); PG8_BAR; PG8_SCHED;
            PG8_STAGE(PG8_SB(1, 1), b3 + hstep, voffB);
            PG8_WAIT_V(6); PG8_BAR; PG8_MMA(1, 1, At, B1); PG8_BAR;
            }
        }
        if constexpr (ALIGN_EPI) { if (wr == 0) PG8_BAR; }
        if constexpr (!Epi::AFTER_DRAIN) { E(acc, cur, wr, wc, fr, fq); S.done(cur); }
        if (!has_next) break;
#pragma unroll
        for (int a = 0; a < 2; ++a)
#pragma unroll
            for (int b = 0; b < 2; ++b)
#pragma unroll
                for (int m = 0; m < 4; ++m)
#pragma unroll
                    for (int n = 0; n < 2; ++n) acc[a][b][m][n] = (f32x4){0.f, 0.f, 0.f, 0.f};
        cur = nxt; cA = nA; cB = nB; ++ui;
        if constexpr (ALIGN_EPI) { if (wr == 1) PG8_BAR; }
    }
    PG8_WAIT_V(0);
    if constexpr (!ALIGN_EPI) { if (wr == 0) PG8_BAR; }
    PG8_BAR;
    if constexpr (Epi::AFTER_DRAIN) { E.fused(acc, cur, wr, wc, fr, fq, lds, wid, lane); S.done(cur); }
#undef PG8_SA
#undef PG8_SB
#undef PG8_STAGE
#undef PG8_LDA
#undef PG8_LDB
#undef PG8_MMA
#undef PG8_WAIT_V
#undef PG8_WAIT_L
#undef PG8_BAR
#undef PG8_SCHED
}
}

#ifndef PG8_SP2
#define PG8_SP2 true
#endif
#ifndef PG8_ALIGN
#define PG8_ALIGN true
#endif
#include <hip/hip_bf16.h>
#include <cmath>
namespace attn_body {
using bf16=__hip_bfloat16;
using bf16x8=__attribute__((ext_vector_type(8)))short;
using s16x4=__attribute__((ext_vector_type(4)))short;
using f32x16=__attribute__((ext_vector_type(16)))float;
using u32x4=__attribute__((ext_vector_type(4)))unsigned;
constexpr int BATCH=8,NHEAD=8,SEQ=2048,D=64,DM=NHEAD*D;
constexpr int NW=8,QBLK=32,QB=QBLK*NW,KVBLK=64,NQB=SEQ/QB;
constexpr int ATTN_PITCH=DM, ATTN_UNIT_ROWS=QB;
__device__ __forceinline__ int crow(int r,int hi){return (r&3)+8*(r>>2)+4*hi;}
#define SBAR() __builtin_amdgcn_sched_barrier(0)
__device__ __forceinline__ void cmask(f32x16&p0,f32x16&p1,int jb,int qrel,int hi){
  const float NEG=-INFINITY; int kb=64*jb+4*hi;
  #pragma unroll
  for(int r=0;r<16;++r){int kv=kb+(r&3)+8*(r>>2); if(kv>qrel)p0[r]=NEG; if(kv+32>qrel)p1[r]=NEG;}
}

constexpr int NSLOT=3, SLOTB=8192;
constexpr int LDS_K=0, LDS_V=NSLOT*SLOTB, LDS_WS=2*NSLOT*SLOTB, LDS_OST=LDS_WS+NW*64*4, LDS_FL=LDS_OST+NW*4096, LDS_BYTES=LDS_FL+SEQ*4;
typedef float f32x4_ __attribute__((ext_vector_type(4)));
constexpr float C2=0.125f*1.4426950408889634f;
__device__ __forceinline__ void glds16(const void*gsrc,unsigned lds_dst){unsigned keep;
  asm volatile("s_mov_b32 %0, m0\n\ts_mov_b32 m0, %2\n\ts_nop 0\n\tglobal_load_lds_dwordx4 %1, off\n\ts_mov_b32 m0, %0":"=&s"(keep):"v"(gsrc),"s"(lds_dst):"memory");}
__device__ __forceinline__ float max3f(float a,float b,float c){float r;asm("v_max3_f32 %0, %1, %2, %3":"=v"(r):"v"(a),"v"(b),"v"(c));return r;}
__device__ __forceinline__ float max2f(float a,float b){float r;asm("v_max_f32_e32 %0, %1, %2":"=v"(r):"v"(a),"v"(b));return r;}
__device__ __forceinline__ float fadd_s(float a,float b){float r;asm("v_add_f32_e32 %0, %1, %2":"=v"(r):"v"(a),"v"(b));return r;}
__device__ __forceinline__ float fsub_s(float a,float b){float r;asm("v_sub_f32_e32 %0, %1, %2":"=v"(r):"v"(a),"v"(b));return r;}
typedef float f32x2_t __attribute__((ext_vector_type(2))); typedef __bf16 bf16x2_t __attribute__((ext_vector_type(2)));
__device__ __forceinline__ unsigned cvtpk_s(float lo,float hi){f32x2_t v={lo,hi};bf16x2_t b=__builtin_convertvector(v,bf16x2_t);return __builtin_bit_cast(unsigned,b);}
#define WAIT_BAR(N) asm volatile("s_waitcnt vmcnt(" #N ") lgkmcnt(0)\n\ts_barrier":::"memory")

__device__ __forceinline__ void qkt(f32x16&p0,f32x16&p1,const char*Kslot,const bf16x8*qr,const f32x16&negm,int r32,int hi){
  const char*kb=Kslot+hi*1024+r32*16;
  #pragma unroll
  for(int d0=0;d0<4;++d0){
    const bf16x8 b0=*reinterpret_cast<const bf16x8*>(kb+d0*2048);
    const bf16x8 b1=*reinterpret_cast<const bf16x8*>(kb+d0*2048+512);
    if(d0==0){p0=__builtin_amdgcn_mfma_f32_32x32x16_bf16(b0,qr[0],negm,0,0,0);p1=__builtin_amdgcn_mfma_f32_32x32x16_bf16(b1,qr[0],negm,0,0,0);}
    else{p0=__builtin_amdgcn_mfma_f32_32x32x16_bf16(b0,qr[d0],p0,0,0,0);p1=__builtin_amdgcn_mfma_f32_32x32x16_bf16(b1,qr[d0],p1,0,0,0);}}
}
typedef __attribute__((address_space(3))) const char* lds_cptr;
typedef short v4i16_t __attribute__((ext_vector_type(4)));
__device__ __forceinline__ void kload8(bf16x8*kf,lds_cptr kp){
  kf[0]=*(const __attribute__((address_space(3))) bf16x8*)(kp);      kf[1]=*(const __attribute__((address_space(3))) bf16x8*)(kp+512);
  kf[2]=*(const __attribute__((address_space(3))) bf16x8*)(kp+2048); kf[3]=*(const __attribute__((address_space(3))) bf16x8*)(kp+2560);
  kf[4]=*(const __attribute__((address_space(3))) bf16x8*)(kp+4096); kf[5]=*(const __attribute__((address_space(3))) bf16x8*)(kp+4608);
  kf[6]=*(const __attribute__((address_space(3))) bf16x8*)(kp+6144); kf[7]=*(const __attribute__((address_space(3))) bf16x8*)(kp+6656);
}
__device__ __forceinline__ void kload2(bf16x8*kf,lds_cptr kp,int j){ kf[2*j]=*(const __attribute__((address_space(3))) bf16x8*)(kp+j*2048); kf[2*j+1]=*(const __attribute__((address_space(3))) bf16x8*)(kp+j*2048+512); }
__device__ __forceinline__ s16x4 vtr(lds_cptr p){ return __builtin_bit_cast(s16x4,__builtin_amdgcn_ds_read_tr16_b64_v4i16((__attribute__((address_space(3))) v4i16_t*)p)); }
__device__ __forceinline__ float rowmax(const f32x16&p0,const f32x16&p1){
  float a=max3f(p0[0],p0[1],p1[0]),b=max3f(p0[2],p0[3],p1[1]);a=max3f(a,p1[2],p1[3]);
  #pragma unroll
  for(int r=4;r<16;r+=4){a=max3f(a,p0[r],p0[r+1]);b=max3f(b,p0[r+2],p0[r+3]);a=max3f(a,p1[r],p1[r+1]);b=max3f(b,p1[r+2],p1[r+3]);}
  const float m=max2f(a,b);
  auto rr=__builtin_amdgcn_permlane32_swap(__float_as_uint(m),__float_as_uint(m),false,false);
  return max2f(__uint_as_float(rr[0]),__uint_as_float(rr[1]));
}
__device__ __forceinline__ void pv(f32x16*o,int vb,bf16x8 pa0,bf16x8 pa1,bf16x8 pa2,bf16x8 pa3){
  #pragma unroll
  for(int d0=0;d0<2;++d0){s16x4 lo[4],hi[4];
    #pragma unroll
    for(int ks=0;ks<4;++ks){
      asm volatile("ds_read_b64_tr_b16 %0,%1 offset:%c2":"=&v"(lo[ks]):"v"(vb),"i"(d0*4096+ks*1024):"memory");
      asm volatile("ds_read_b64_tr_b16 %0,%1 offset:%c2":"=&v"(hi[ks]):"v"(vb),"i"(d0*4096+ks*1024+512):"memory");}
    asm volatile("s_waitcnt lgkmcnt(0)":::"memory");SBAR();
    #define PK(k) (bf16x8){lo[k][0],lo[k][1],lo[k][2],lo[k][3],hi[k][0],hi[k][1],hi[k][2],hi[k][3]}
    o[d0]=__builtin_amdgcn_mfma_f32_32x32x16_bf16(pa0,PK(0),o[d0],0,0,0);
    o[d0]=__builtin_amdgcn_mfma_f32_32x32x16_bf16(pa1,PK(1),o[d0],0,0,0);
    o[d0]=__builtin_amdgcn_mfma_f32_32x32x16_bf16(pa2,PK(2),o[d0],0,0,0);
    o[d0]=__builtin_amdgcn_mfma_f32_32x32x16_bf16(pa3,PK(3),o[d0],0,0,0);
    #undef PK
  }
}

#ifndef ATTN_STORE16
#define ATTN_STORE16(p,v) (*(u32x4*)(p)=(v))
#endif
template<int THRL> __device__ __forceinline__ void attn_unit(int b,int h,int qb,const bf16*Q,const bf16*__restrict__ K,const bf16*__restrict__ V,bf16*O,const float*fcrow,char*shm){
  int tid_=threadIdx.x; asm volatile("":"+v"(tid_)); const int tid=tid_,lane=tid&63,r32=lane&31,hi=lane>>5; const int wid=__builtin_amdgcn_readfirstlane(tid>>6);
  { const f32x4_ fv=*(const f32x4_*)(fcrow+4*tid); *(f32x4_*)((float*)(shm+LDS_FL)+4*tid)=fv*(-1.4426950408889634f); }
  const long rowbase=(long)b*SEQ; const int q0=qb*QB;
  const bf16*Qw=Q+(rowbase+q0+wid*QBLK)*DM+h*D;
  const bf16*Kh=K+rowbase*DM+h*D,*Vh=V+rowbase*DM+h*D;
  const unsigned lds0=(unsigned)(uintptr_t)shm;
  float*wsf=(float*)(shm+LDS_WS)+wid*64;
  const bf16*ksrc=Kh+(long)lane*DM+wid*8;
  const bf16*vsrc=Vh+(long)(16*(wid&3)+(lane>>2))*DM+(wid>>2)*32+(lane&3)*8;
  const unsigned kdst=lds0+LDS_K+wid*1024, vdst=lds0+LDS_V+wid*1024;
  #define DMA_K(t,slot) glds16(ksrc+(long)(t)*KVBLK*DM,(unsigned)__builtin_amdgcn_readfirstlane(kdst+(slot)))
  #define DMA_V(t,slot) glds16(vsrc+(long)(t)*KVBLK*DM,(unsigned)__builtin_amdgcn_readfirstlane(vdst+(slot)))
  const int vb0=(int)(lds0+LDS_V)+((lane>>4)&1)*32+(lane&3)*8+(4*hi+((lane&15)>>2))*64;
  const char*Kbase=shm+LDS_K; bf16x8 kf[8];
  const lds_cptr shm3=(lds_cptr)shm; const __attribute__((address_space(3))) float* fl3=(const __attribute__((address_space(3))) float*)(shm3+LDS_FL)+4*hi; const lds_cptr kp0=shm3+LDS_K+hi*1024+r32*16; const lds_cptr vp0=shm3+LDS_V+((lane>>4)&1)*32+(lane&3)*8+(4*hi+((lane&15)>>2))*64;
  const int NT=(q0+QB)/KVBLK;
  DMA_K(0,0);DMA_V(0,0);DMA_K(1,SLOTB);
  bf16x8 qr[4];
  #pragma unroll
  for(int d0=0;d0<4;++d0)qr[d0]=*reinterpret_cast<const bf16x8*>(&Qw[(long)r32*DM+d0*16+hi*8]);
  float zz_=0.f; asm volatile("":"+v"(zz_));
  float mhat=zz_,l_reg=zz_;f32x16 o[2];f32x16 negm;
  #pragma unroll
  for(int r=0;r<16;++r){o[0][r]=zz_;o[1][r]=zz_;negm[r]=zz_;}
  asm volatile("":"+v"(negm));
  const int qrel=wid*QBLK+r32;
  #define CMASK(P0,P1,t) do{int jb_=(t)-(NT-4); if(jb_>=0)cmask(P0,P1,jb_,qrel,hi);}while(0)
  bool resc=false;
  #define START(P0,P1) do{ const float rm=rowmax(P0,P1); resc=false; \
    { const float dl=rm; mhat=fadd_s(mhat,dl); \
      _Pragma("unroll") for(int r=0;r<16;++r){P0[r]=fsub_s(P0[r],dl);P1[r]=fsub_s(P1[r],dl);} \
      _Pragma("unroll") for(int r=0;r<16;++r)negm[r]=-mhat; asm volatile("":"+v"(negm)); } \
    _Pragma("unroll") for(int r=0;r<16;++r)P0[r]=__builtin_amdgcn_exp2f(P0[r]); }while(0)
  #define RESC() do{ if(resc){ asm volatile("s_waitcnt lgkmcnt(0)":::"memory"); \
      _Pragma("unroll") for(int d_=0;d_<2;++d_) _Pragma("unroll") for(int r=0;r<16;++r)o[d_][r]*=wsf[crow(r,hi)]; } }while(0)
  f32x16 pA0,pA1,pB0,pB1;
  int sl_prev=0,sl_cur=0,sl_next=SLOTB;
  #define ROT() do{sl_prev=sl_cur;sl_cur=sl_next;sl_next=(sl_next==(NSLOT-1)*SLOTB)?0:sl_next+SLOTB;}while(0)
  DMA_K(2,2*SLOTB);
  WAIT_BAR(3);
  #define FBIAS(P0,P1,t) do{ const __attribute__((address_space(3))) float* fb_=fl3+64*(t); \
    _Pragma("unroll") for(int g_=0;g_<4;++g_){ const f32x4_ b0_=*(const __attribute__((address_space(3))) f32x4_*)(fb_+8*g_); const f32x4_ b1_=*(const __attribute__((address_space(3))) f32x4_*)(fb_+32+8*g_); \
      P0[4*g_]+=b0_[0];P0[4*g_+1]+=b0_[1];P0[4*g_+2]+=b0_[2];P0[4*g_+3]+=b0_[3]; P1[4*g_]+=b1_[0];P1[4*g_+1]+=b1_[1];P1[4*g_+2]+=b1_[2];P1[4*g_+3]+=b1_[3]; } }while(0)
  qkt(pA0,pA1,Kbase,qr,negm,r32,hi);asm volatile("s_nop 15\n\ts_nop 7":"+v"(pA0),"+v"(pA1));FBIAS(pA0,pA1,0);CMASK(pA0,pA1,0);
  START(pA0,pA1);
  _Pragma("unroll") for(int r=0;r<16;++r)pA1[r]=__builtin_amdgcn_exp2f(pA1[r]);
  WAIT_BAR(0);
  DMA_K(3,0);DMA_V(1,SLOTB);
  ROT();
  kload8(kf,kp0+sl_cur);
  WAIT_BAR(2);
  s16x4 vlo[8],vhi[8]; u32x4 pw0,pw1,pw2,pw3;
  #define PKW(P,B) cvtpk_s(P[B],P[B+1])
  #define PAF(k) __builtin_bit_cast(bf16x8,pw##k)
  #define VFR(i) (bf16x8){vlo[i][0],vlo[i][1],vlo[i][2],vlo[i][3],vhi[i][0],vhi[i][1],vhi[i][2],vhi[i][3]}
  #define PIN(x) asm volatile("":"+v"(x))
  #define MX3(a,b,c) __builtin_fmaxf(__builtin_fmaxf((a),(b)),(c))
  #define GAPA(MF,A0,A1,A2,A3,W0,W1,PW) do{ MF; sacc+=A0; sacc+=A1; sacc+=A2; sacc+=A3; PIN(sacc); W0; W1; PIN(PW); SBAR(); }while(0)
  #define EX(v) __builtin_amdgcn_exp2f(v)
  #define GAPB(MF,X,B) do{ MF; X[B]=EX(X[B]); X[B+1]=EX(X[B+1]); X[B+2]=EX(X[B+2]); X[B+3]=EX(X[B+3]); PIN(X); SBAR(); }while(0)
  #define VRD(i) do{ vlo[i]=vtr(vp_+(((i)>>2)*4096+((i)&3)*1024)); vhi[i]=vtr(vp_+(((i)>>2)*4096+((i)&3)*1024+512)); }while(0)
  #define KRD(G,j) do{ if(G){ kload2(kf,kp0+sl_next,j); SBAR(); } }while(0)
  #define STEP(C0,C1,P0,P1,t,GK,GV,GL) do{ SBAR(); \
    const lds_cptr vp_=vp0+sl_prev; \
    VRD(0); SBAR(); float sacc=(P0[0]+P0[1]); \
    GAPA(C0=__builtin_amdgcn_mfma_f32_32x32x16_bf16(kf[0],qr[0],negm,0,0,0), P0[2],P0[3],P0[4],P0[5],     pw0[0]=PKW(P0,0), pw0[1]=PKW(P0,2), pw0); \
    VRD(4); SBAR(); GAPA(C1=__builtin_amdgcn_mfma_f32_32x32x16_bf16(kf[1],qr[0],negm,0,0,0), P0[6],P0[7],P0[8],P0[9],     pw0[2]=PKW(P0,4), pw0[3]=PKW(P0,6), pw0); \
    VRD(1); SBAR(); GAPA(C0=__builtin_amdgcn_mfma_f32_32x32x16_bf16(kf[2],qr[1],C0,0,0,0),   P0[10],P0[11],P0[12],P0[13], pw1[0]=PKW(P0,8), pw1[1]=PKW(P0,10), pw1); \
    VRD(5); SBAR(); GAPA(C1=__builtin_amdgcn_mfma_f32_32x32x16_bf16(kf[3],qr[1],C1,0,0,0),   P0[14],P0[15],P1[0],P1[1],   pw1[2]=PKW(P0,12),pw1[3]=PKW(P0,14), pw1); \
    VRD(2); SBAR(); GAPA(C0=__builtin_amdgcn_mfma_f32_32x32x16_bf16(kf[4],qr[2],C0,0,0,0),   P1[2],P1[3],P1[4],P1[5],     pw2[0]=PKW(P1,0), pw2[1]=PKW(P1,2), pw2); \
    VRD(6); SBAR(); GAPA(C1=__builtin_amdgcn_mfma_f32_32x32x16_bf16(kf[5],qr[2],C1,0,0,0),   P1[6],P1[7],P1[8],P1[9],     pw2[2]=PKW(P1,4), pw2[3]=PKW(P1,6), pw2); \
    VRD(3); SBAR(); GAPA(C0=__builtin_amdgcn_mfma_f32_32x32x16_bf16(kf[6],qr[3],C0,0,0,0),   P1[10],P1[11],P1[12],P1[13], pw3[0]=PKW(P1,8), pw3[1]=PKW(P1,10), pw3); \
    VRD(7); SBAR(); GAPA(C1=__builtin_amdgcn_mfma_f32_32x32x16_bf16(kf[7],qr[3],C1,0,0,0),   P1[14],P1[15],0.f,0.f,       pw3[2]=PKW(P1,12),pw3[3]=PKW(P1,14), pw3); \
    l_reg+=sacc; \
    if(GK){DMA_K((t)+3,sl_cur);} if(GV){DMA_V((t)+1,sl_next);} \
    FBIAS(C0,C1,t); CMASK(C0,C1,t); \
    { float a=MX3(C0[0],C0[1],C1[0]),b=MX3(C0[2],C0[3],C1[1]); a=MX3(a,C1[2],C1[3]); \
      _Pragma("unroll") for(int r=4;r<16;r+=4){a=MX3(a,C0[r],C0[r+1]);b=MX3(b,C0[r+2],C0[r+3]);a=MX3(a,C1[r],C1[r+1]);b=MX3(b,C1[r+2],C1[r+3]);} \
      float rm=__builtin_fmaxf(a,b); { auto rr=__builtin_amdgcn_permlane32_swap(__float_as_uint(rm),__float_as_uint(rm),false,false); rm=__builtin_fmaxf(__uint_as_float(rr[0]),__uint_as_float(rr[1])); } \
      resc=false; \
      if(__builtin_expect(__any(rm>(float)THRL),0)){ const float dl=__builtin_fmaxf(rm,0.f); mhat+=dl; \
        _Pragma("unroll") for(int r=0;r<16;++r){C0[r]-=dl;C1[r]-=dl;} \
        _Pragma("unroll") for(int r=0;r<16;++r)negm[r]=-mhat; asm volatile("":"+v"(negm)); \
        const float f=__builtin_amdgcn_exp2f(-dl); l_reg*=f; if(hi==0)wsf[r32]=f; resc=true; } } \
    SBAR(); \
    GAPB(o[0]=__builtin_amdgcn_mfma_f32_32x32x16_bf16(PAF(0),VFR(0),o[0],0,0,0), C0,0); \
    GAPB(o[1]=__builtin_amdgcn_mfma_f32_32x32x16_bf16(PAF(0),VFR(4),o[1],0,0,0), C0,4); \
    KRD(GL,0); GAPB(o[0]=__builtin_amdgcn_mfma_f32_32x32x16_bf16(PAF(1),VFR(1),o[0],0,0,0), C0,8); \
    KRD(GL,1); GAPB(o[1]=__builtin_amdgcn_mfma_f32_32x32x16_bf16(PAF(1),VFR(5),o[1],0,0,0), C0,12); \
    KRD(GL,2); GAPB(o[0]=__builtin_amdgcn_mfma_f32_32x32x16_bf16(PAF(2),VFR(2),o[0],0,0,0), C1,0); \
    KRD(GL,3); GAPB(o[1]=__builtin_amdgcn_mfma_f32_32x32x16_bf16(PAF(2),VFR(6),o[1],0,0,0), C1,4); \
    GAPB(o[0]=__builtin_amdgcn_mfma_f32_32x32x16_bf16(PAF(3),VFR(3),o[0],0,0,0), C1,8); \
    GAPB(o[1]=__builtin_amdgcn_mfma_f32_32x32x16_bf16(PAF(3),VFR(7),o[1],0,0,0), C1,12); \
    }while(0)
  int t=1;
  #undef CMASK
  #define CMASK(P0,P1,t) do{}while(0)
  for(;t+5<NT;t+=2){
    STEP(pB0,pB1,pA0,pA1,t,true,true,true);     WAIT_BAR(2); RESC(); ROT();
    STEP(pA0,pA1,pB0,pB1,t+1,true,true,true);   WAIT_BAR(2); RESC(); ROT();
  }
  #undef CMASK
  #define CMASK(P0,P1,t) do{int jb_=(t)-(NT-4); if(jb_>=0)cmask(P0,P1,jb_,qrel,hi);}while(0)
  #define ENDW(tt) do{ if((tt)+3<NT){WAIT_BAR(2);} else if((tt)+2<NT){WAIT_BAR(1);} else {WAIT_BAR(0);} }while(0)
  for(;t+1<NT;t+=2){
    STEP(pB0,pB1,pA0,pA1,t,(t+3<NT),(t+1<NT),(t+1<NT));       ENDW(t);   RESC(); ROT();
    STEP(pA0,pA1,pB0,pB1,t+1,(t+4<NT),(t+2<NT),(t+2<NT));     ENDW(t+1); RESC(); ROT();
  }
  STEP(pB0,pB1,pA0,pA1,NT-1,false,false,false); RESC();
  { float sacc=pB0[0]+pB0[1]; _Pragma("unroll") for(int r=2;r<16;++r)sacc+=pB0[r]; _Pragma("unroll") for(int r=0;r<16;++r)sacc+=pB1[r]; l_reg+=sacc;
    pw0=(u32x4){PKW(pB0,0),PKW(pB0,2),PKW(pB0,4),PKW(pB0,6)};pw1=(u32x4){PKW(pB0,8),PKW(pB0,10),PKW(pB0,12),PKW(pB0,14)};pw2=(u32x4){PKW(pB1,0),PKW(pB1,2),PKW(pB1,4),PKW(pB1,6)};pw3=(u32x4){PKW(pB1,8),PKW(pB1,10),PKW(pB1,12),PKW(pB1,14)};
    SBAR(); pv(o,vb0+sl_cur,PAF(0),PAF(1),PAF(2),PAF(3)); }
  #undef PKW
  #undef PAF
  #undef VFR
  #undef PIN
  #undef MX3
  #undef GAPA
  #undef GAPB
  #undef EX
  #undef VRD
  #undef KRD
  #undef STEP
  #undef ENDW
  {auto rr=__builtin_amdgcn_permlane32_swap(__float_as_uint(l_reg),__float_as_uint(l_reg),false,false);l_reg=__uint_as_float(rr[0])+__uint_as_float(rr[1]);}
  if(hi==0)wsf[32+r32]=l_reg;asm volatile("s_waitcnt lgkmcnt(0)":::"memory");
  float rli[16];
  #pragma unroll
  for(int r=0;r<16;++r)rli[r]=__builtin_amdgcn_rcpf(wsf[32+crow(r,hi)]);
  bf16*Ow=O+(rowbase+q0+wid*QBLK)*DM+h*D;
  { bf16*stg=(bf16*)(shm+LDS_OST)+wid*2048;
    #pragma unroll
    for(int r=0;r<16;++r){const int orow=crow(r,hi);
      #pragma unroll
      for(int d0=0;d0<2;++d0)stg[orow*64+d0*32+r32]=__float2bfloat16(o[d0][r]*rli[r]);}
    asm volatile("s_waitcnt lgkmcnt(0)":::"memory");
    #pragma unroll
    for(int i=0;i<4;++i){const int row=i*8+(lane>>3),ch=lane&7; const u32x4 v=*(const u32x4*)(stg+row*64+ch*8); ATTN_STORE16(Ow+(long)row*DM+ch*8,v);} }
  asm volatile("s_waitcnt lgkmcnt(0)\n\ts_barrier":::"memory");
  #undef FBIAS
  #undef DMA_K
  #undef DMA_V
  #undef CMASK
  #undef START
  #undef RESC
  #undef ROT
}
constexpr int ATTN_LDS_BYTES=LDS_BYTES;
struct AttnTensors { const bf16* Q; const bf16* K; const bf16* V; bf16* O; const float* fc; };
struct AttnUnit { int bh; int qb; };
struct StaticOrder {
  int vcu;
  __device__ __forceinline__ explicit StaticOrder(int grid,int block):vcu((block%8)*(grid/8)+block/8){}
  __device__ __forceinline__ bool next(int i,AttnUnit&u)const{ if(i>=2)return false; const int s=vcu&3; u.bh=vcu>>2; u.qb=(i==0)?7-s:s; return true; }
  __device__ __forceinline__ void a_ready(const AttnUnit&)const{}
  __device__ __forceinline__ void done(const AttnUnit&)const{}
};
template<class Sched,int THRL=8> __device__ __forceinline__ void attn_phase(char*lds,const AttnTensors&T,const Sched&S){
  AttnUnit u;
  for(int i=0;S.next(i,u);++i){ S.a_ready(u); attn_unit<THRL>(u.bh/NHEAD,u.bh%NHEAD,u.qb,T.Q,T.K,T.V,T.O,T.fc+(long)u.bh*SEQ,lds); S.done(u); }
}
#undef SBAR
#undef WAIT_BAR
}
namespace attn_body {
#define SBAR() __builtin_amdgcn_sched_barrier(0)
constexpr int DQ_PITCH = 768, DO_PITCH = 256, MROWS = BATCH * SEQ;
constexpr int DL_K = 0, DL_V = 6 * 8192, DL_OST = 12 * 8192, DL_WS = 131584;
struct DilTensors { const bf16* Q; const bf16* K; const bf16* V; bf16* OG; float* LSE; };

__device__ __forceinline__ void dil_unit(int u, const DilTensors& T, char* shm) {
  int tid_ = threadIdx.x; asm volatile("" : "+v"(tid_)); const int tid = tid_, lane = tid & 63, r32 = lane & 31, hi = lane >> 5; const int wid = __builtin_amdgcn_readfirstlane(tid >> 6);
  const int bhs = u / 24, k = u % 24, g = k >> 3, p = k & 7, b = bhs >> 2, hs = bhs & 3, head = g * 4 + hs;
  const int dil = (g == 0) ? 1 : (g == 1 ? 4 : 16);
  int res0, n0; if (g == 0) { res0 = 0; n0 = 2 * p; } else if (g == 1) { res0 = p >> 1; n0 = 2 * (p & 1); } else { res0 = 2 * p; n0 = 0; }
  const int hf = wid >> 2, wq = wid & 3;
  const bool has_prev = (g < 2) && (n0 + hf > 0);
  const long rowbase = (long)b * SEQ;
  #define DBASE(j) ((g < 2) ? (res0 + dil * (128 * (n0 - 1) + 64 * (j))) : (res0 - 1 + ((j) >> 1) + 1024 * ((j) & 1)))
  const unsigned lds0 = (unsigned)(uintptr_t)shm;
  float* wsf = (float*)(shm + DL_WS) + wid * 64;
  const int jlo = (g < 2 && n0 > 0) ? 0 : 2;
  { const bf16* Kh = T.K + rowbase * DQ_PITCH + head * D + wid * 8; const bf16* Vh = T.V + rowbase * DQ_PITCH + head * D + (wid >> 2) * 32 + (lane & 3) * 8;
    const int vrow = 16 * (wid & 3) + (lane >> 2);
    for (int j = jlo; j < 6; ++j) { const int tb = DBASE(j);
      glds16(Kh + (long)(tb + dil * lane) * DQ_PITCH, (unsigned)__builtin_amdgcn_readfirstlane(lds0 + DL_K + j * 8192 + wid * 1024));
      glds16(Vh + (long)(tb + dil * vrow) * DQ_PITCH, (unsigned)__builtin_amdgcn_readfirstlane(lds0 + DL_V + j * 8192 + wid * 1024)); } }
  const int ql = 32 * wq + r32, qtok0 = DBASE(2 * hf + 2);
  bf16x8 qr[4];
  { const bf16* Qw = T.Q + (rowbase + qtok0 + dil * ql) * DQ_PITCH + head * D + hi * 8;
    #pragma unroll
    for (int d0 = 0; d0 < 4; ++d0) qr[d0] = *reinterpret_cast<const bf16x8*>(Qw + d0 * 16); }
  asm volatile("s_waitcnt vmcnt(0) lgkmcnt(0)\n\ts_barrier" ::: "memory");
  float m = -INFINITY, l = 0.f; f32x16 o[2]; o[0] = f32x16{}; o[1] = f32x16{};
  const f32x16 zero16 = f32x16{};
  const int vb0 = (int)(lds0 + DL_V) + ((lane >> 4) & 1) * 32 + (lane & 3) * 8 + (4 * hi + ((lane & 15) >> 2)) * 64;
  #pragma unroll
  for (int s = 0; s < 4; ++s) {
    const bool is_prev = s < 2; const int jt = s & 1;
    if (is_prev && !has_prev) continue;
    if (is_prev && jt == 0 && wq >= 2) continue;
    if (!is_prev && jt == 1 && wq < 2) continue;
    const int j = 2 * hf + s;
    f32x16 p0, p1;
    qkt(p0, p1, shm + DL_K + j * 8192, qr, zero16, r32, hi);
    asm volatile("s_nop 15\n\ts_nop 7" : "+v"(p0), "+v"(p1));
    #pragma unroll
    for (int r = 0; r < 16; ++r) { const int key = 64 * jt + crow(r, hi);
      if (is_prev) { if (key < ql) p0[r] = -INFINITY; if (key + 32 < ql) p1[r] = -INFINITY; }
      else         { if (key > ql) p0[r] = -INFINITY; if (key + 32 > ql) p1[r] = -INFINITY; } }
    const float rm = rowmax(p0, p1), mn = __builtin_fmaxf(m, rm), f = __builtin_amdgcn_exp2f(m - mn); m = mn;
    float sacc = 0.f;
    #pragma unroll
    for (int r = 0; r < 16; ++r) { p0[r] = __builtin_amdgcn_exp2f(p0[r] - mn); p1[r] = __builtin_amdgcn_exp2f(p1[r] - mn); sacc += p0[r] + p1[r]; }
    l = l * f + sacc;
    if (hi == 0) wsf[r32] = f;
    asm volatile("s_waitcnt lgkmcnt(0)" ::: "memory");
    #pragma unroll
    for (int d_ = 0; d_ < 2; ++d_)
      #pragma unroll
      for (int r = 0; r < 16; ++r) o[d_][r] *= wsf[crow(r, hi)];
    u32x4 pw0, pw1, pw2, pw3;
    pw0 = (u32x4){cvtpk_s(p0[0], p0[1]), cvtpk_s(p0[2], p0[3]), cvtpk_s(p0[4], p0[5]), cvtpk_s(p0[6], p0[7])};
    pw1 = (u32x4){cvtpk_s(p0[8], p0[9]), cvtpk_s(p0[10], p0[11]), cvtpk_s(p0[12], p0[13]), cvtpk_s(p0[14], p0[15])};
    pw2 = (u32x4){cvtpk_s(p1[0], p1[1]), cvtpk_s(p1[2], p1[3]), cvtpk_s(p1[4], p1[5]), cvtpk_s(p1[6], p1[7])};
    pw3 = (u32x4){cvtpk_s(p1[8], p1[9]), cvtpk_s(p1[10], p1[11]), cvtpk_s(p1[12], p1[13]), cvtpk_s(p1[14], p1[15])};
    SBAR();
    pv(o, vb0 + j * 8192, __builtin_bit_cast(bf16x8, pw0), __builtin_bit_cast(bf16x8, pw1), __builtin_bit_cast(bf16x8, pw2), __builtin_bit_cast(bf16x8, pw3));
    asm volatile("s_nop 15\n\ts_nop 7" : "+v"(o[0]), "+v"(o[1]));
  }
  { auto rr = __builtin_amdgcn_permlane32_swap(__float_as_uint(l), __float_as_uint(l), false, false); l = __uint_as_float(rr[0]) + __uint_as_float(rr[1]); }
  if (hi == 0) { T.LSE[((long)g * MROWS + rowbase + qtok0 + dil * ql) * 4 + hs] = m + __builtin_amdgcn_logf(l); wsf[32 + r32] = l; }
  asm volatile("s_waitcnt lgkmcnt(0)" ::: "memory");
  float rli[16];
  #pragma unroll
  for (int r = 0; r < 16; ++r) rli[r] = __builtin_amdgcn_rcpf(wsf[32 + crow(r, hi)]);
  { bf16* stg = (bf16*)(shm + DL_OST) + wid * 2048;
    #pragma unroll
    for (int r = 0; r < 16; ++r) { const int orow = crow(r, hi);
      #pragma unroll
      for (int d0 = 0; d0 < 2; ++d0) stg[orow * 64 + d0 * 32 + r32] = __float2bfloat16(o[d0][r] * rli[r]); }
    asm volatile("s_waitcnt lgkmcnt(0)" ::: "memory");
    bf16* Og = T.OG + ((long)g * MROWS + rowbase) * DO_PITCH + hs * D;
    #pragma unroll
    for (int i = 0; i < 4; ++i) { const int row = i * 8 + (lane >> 3), ch = lane & 7; const u32x4 v = *(const u32x4*)(stg + row * 64 + ch * 8);
      *(u32x4*)(Og + (long)(qtok0 + dil * (32 * wq + row)) * DO_PITCH + ch * 8) = v; } }
  asm volatile("s_waitcnt lgkmcnt(0)\n\ts_barrier" ::: "memory");
  #undef DBASE
}
#undef SBAR
}
#define GAS __attribute__((address_space(1)))
#define LAS __attribute__((address_space(3)))
typedef unsigned short bf16;
typedef unsigned v4u __attribute__((ext_vector_type(4)));
typedef float f32x4 __attribute__((ext_vector_type(4)));
typedef short bf16x8 __attribute__((ext_vector_type(8)));
typedef GAS unsigned gu32;
typedef GAS unsigned long long gu64;
#define RLX_AGENT __ATOMIC_RELAXED, __HIP_MEMORY_SCOPE_AGENT
#define LDS_WAIT() asm volatile("s_waitcnt lgkmcnt(0)" ::: "memory")
#define VM_WAIT() asm volatile("s_waitcnt vmcnt(0)" ::: "memory")
__device__ __forceinline__ unsigned long long rt() { return __builtin_amdgcn_s_memrealtime(); }
__device__ __forceinline__ unsigned f2bf(float f) { unsigned u = __builtin_bit_cast(unsigned, f); return (u + 0x7fffu + ((u >> 16) & 1u)) >> 16; }
__device__ __forceinline__ unsigned pk2(float lo, float hi) { return f2bf(lo) | (f2bf(hi) << 16); }

#define XB_TMO      128
#define XB_XCNT(j)  (256  + 64 * (j))
#define XB_XSUB(j)  (1280 + 64 * (j))
#define XB_XGEN(j)  (2304 + 64 * (j))
#define XB_TOP      3328
#define XB_TOPGEN   3392
#define XCD_BAR_WORDS 3456
#define XB_SPIN_CAP (1u << 22)

__device__ __forceinline__ unsigned xb_ld(unsigned* p)              { return __hip_atomic_load(p, __ATOMIC_RELAXED, __HIP_MEMORY_SCOPE_AGENT); }
__device__ __forceinline__ unsigned xb_add(unsigned* p, unsigned v) { return __hip_atomic_fetch_add(p, v, __ATOMIC_RELAXED, __HIP_MEMORY_SCOPE_AGENT); }
__device__ __forceinline__ unsigned xb_xcc_id() { return (unsigned)__builtin_amdgcn_s_getreg((3 << 11) | 20) & 0xFu; }
#define XB_SPIN(cond, bar) do { unsigned _sp = 0; while (cond) { __builtin_amdgcn_s_sleep(1); \
    if ((++_sp & 255u) == 0u) { if (xb_ld(&(bar)[XB_TMO])) break; if (_sp > XB_SPIN_CAP) { atomicAdd(&(bar)[XB_TMO], 1u); break; } } } } while (0)

struct XcdBarrier {
    unsigned* bar; unsigned x;
    volatile LAS unsigned* st;
};

__device__ __forceinline__ XcdBarrier xcd_barrier_post(unsigned* bar, volatile LAS unsigned* st) {
    XcdBarrier b; b.bar = bar; b.x = xb_xcc_id(); b.st = st;
    if (threadIdx.x == 0) (void)xb_add(&bar[XB_XCNT(b.x)], 1u);
    return b;
}
__device__ __forceinline__ void xcd_barrier_complete(unsigned* bar, unsigned x, unsigned& nloc, unsigned& nx) {
    const unsigned G = gridDim.x * gridDim.y * gridDim.z;
    unsigned sum, cnt, mine, sp = 0u;
    for (;;) {
        sum = 0u; cnt = 0u; mine = 0u;
#pragma unroll
        for (unsigned j = 0; j < 16; ++j) { const unsigned c = xb_ld(&bar[XB_XCNT(j)]); sum += c; cnt += (c > 0u) ? 1u : 0u; mine = (j == x) ? c : mine; }
        if (sum == G) break;
        __builtin_amdgcn_s_sleep(1);
        if ((++sp & 255u) == 0u) { if (xb_ld(&bar[XB_TMO])) break; if (sp > XB_SPIN_CAP) { atomicAdd(&bar[XB_TMO], 1u); break; } }
    }
    nloc = mine > 0u ? mine : 1u; nx = cnt > 0u ? cnt : 1u;
}

__device__ __forceinline__ void xcd_barrier(const XcdBarrier& b) {
    asm volatile("s_waitcnt vmcnt(0)" ::: "memory");
    __syncthreads();
    if (threadIdx.x == 0) {
        unsigned* bar = b.bar;
        __builtin_amdgcn_s_waitcnt(0);
        unsigned nloc = b.st[0], nx = b.st[1];
        if (nloc == 0u) { xcd_barrier_complete(bar, b.x, nloc, nx); b.st[0] = nloc; b.st[1] = nx; }
        const unsigned old = xb_add(&bar[XB_XSUB(b.x)], 1u);
        const unsigned gen = old / nloc;
        if (old + 1u == (gen + 1u) * nloc) {
            __builtin_amdgcn_fence(__ATOMIC_RELEASE, "agent");
            asm volatile("s_waitcnt vmcnt(0)" ::: "memory");
            const unsigned og = xb_add(&bar[XB_TOP], 1u);
            const unsigned tg = og / nx;
            if (og + 1u == (tg + 1u) * nx) xb_add(&bar[XB_TOPGEN], 1u);
            else XB_SPIN(xb_ld(&bar[XB_TOPGEN]) == tg, bar);
            __builtin_amdgcn_fence(__ATOMIC_ACQUIRE, "agent");
            xb_add(&bar[XB_XGEN(b.x)], 1u);
            asm volatile("s_waitcnt vmcnt(0)" ::: "memory");
        } else {
            XB_SPIN(xb_ld(&bar[XB_XGEN(b.x)]) == gen, bar);
            __builtin_amdgcn_fence(__ATOMIC_ACQUIRE, "agent");
            asm volatile("s_waitcnt vmcnt(0)" ::: "memory");
        }
    }
    __syncthreads();
}
constexpr int NWAVES = 8;
constexpr int BATCH = 8, SEQ = 2048, D = 1024, M = BATCH * SEQ;
constexpr int FOX_W = 512, DIL_W = 768, DIL_OUT_W = 256, D_FF = 2816, IN_COLS = 5896, N_IN = 5888, N_GU = 5632, C_FA = 1536;
constexpr float EPS = 1e-6f, LOG2E = 1.4426950408889634f, C2 = 0.125f * 1.4426950408889634f;
constexpr int MOD_SH_M = 0, MOD_SC_M = 1024, MOD_GA_M = 2048, MOD_SH_F = 3072, MOD_SC_F = 4096, MOD_GA_F = 5120;

constexpr size_t MiB = 1u << 20;
constexpr size_t WS_CTL = 0, CTL_ZERO_BYTES = 64 * 1024;
constexpr size_t WS_MOD = 1 * MiB;
constexpr size_t WS_ROPE = WS_MOD + 256 * 1024;
constexpr size_t WS_LF = WS_MOD + 512 * 1024;
constexpr size_t WS_FC = 2 * MiB;
constexpr size_t WS_WIN = 3 * MiB;
constexpr size_t WS_WBRA = 15 * MiB;
constexpr size_t WS_WBRB = 16 * MiB;
constexpr size_t WS_WOUT = 17 * MiB;
constexpr size_t WS_WGU = 19 * MiB;
constexpr size_t WS_WDN = 30 * MiB;
constexpr size_t WS_XN = 36 * MiB;
constexpr size_t WS_YA = 36 * MiB, WS_YB = 52 * MiB, WS_H2 = 36 * MiB;
constexpr size_t WS_FOX = 68 * MiB;
constexpr size_t WS_DIL = 116 * MiB;
constexpr size_t WS_GATE = 188 * MiB;
constexpr size_t WS_END = 252 * MiB;
constexpr size_t WS_MERGED = WS_FOX;
constexpr size_t WS_ACT = WS_FOX;
constexpr int CW_BAR = 4096;

constexpr int RING_OFF = 0, RING_BYTES = 131072;
constexpr int LDSCTL_OFF = RING_BYTES, MISC_OFF = LDSCTL_OFF + 320;
constexpr int LDS_BYTES = 147456;

struct Frame {
    LAS unsigned char* lds;
    volatile LAS unsigned* MISC;
    gu32* ctl;
    int tid, lane, wave, vcu, G;
};
__device__ __forceinline__ float wave_sum(float v) {
#pragma unroll
    for (int o = 1; o < 64; o <<= 1) v += __shfl_xor(v, o);
    return v;
}
__device__ __forceinline__ float bf2f(unsigned short h) { return __uint_as_float(((unsigned)h) << 16); }
__device__ __forceinline__ float fast_sigmoid(float x) { return __builtin_amdgcn_rcpf(1.f + __builtin_amdgcn_exp2f(-LOG2E * x)); }

namespace pg8 {
struct EpiInProj {
    static constexpr bool PERM = true, AFTER_DRAIN = false;
    bf16_t* fox; bf16_t* dil; bf16_t* gate; const float* rope;
    __device__ __forceinline__ void operator()(const f32x4 (&acc)[2][2][4][2], const Unit& u, int wr, int wc, int fr, int fq) const {
        const int pn = u.pn; bf16_t* base; int ldc, colt; float sc = 1.f; bool rope_on = false;
        if (pn < 6) { const int s = pn >> 1; base = fox + (size_t)s * M * FOX_W; ldc = FOX_W; colt = (pn & 1) * 256; if (s == 0) sc = C2; }
        else if (pn < 15) { const int q = pn - 6, s = q / 3; base = dil + (size_t)s * M * DIL_W; ldc = DIL_W; colt = (q - 3 * s) * 256; if (s == 0) sc = C2; rope_on = (s < 2) && ((wc & 1) == 0); }
        else { const int q = pn - 15, s = q >> 2; base = gate + (size_t)s * M * D; ldc = D; colt = (q & 3) * 256; }
        const int row0 = u.pm * BM + wr * 64 + fr, col0 = colt + wc * 32 + 8 * fq;
#pragma unroll
        for (int ai = 0; ai < 2; ++ai)
#pragma unroll
            for (int m = 0; m < 4; ++m) {
                const int row = row0 + ai * HALF + m * 16; bf16_t* rowp = base + (size_t)row * ldc + col0;
                f32x4 c0, s0, c1, s1;
                if (rope_on) { const f32x4* tp = (const f32x4*)(rope + (size_t)(row & (SEQ - 1)) * 16); const f32x4 t0 = tp[0], t1 = tp[1], t2 = tp[2], t3 = tp[3];
                    c0 = (f32x4){t0[0], t0[2], t1[0], t1[2]}; s0 = (f32x4){t0[1], t0[3], t1[1], t1[3]}; c1 = (f32x4){t2[0], t2[2], t3[0], t3[2]}; s1 = (f32x4){t2[1], t2[3], t3[1], t3[3]}; }
#pragma unroll
                for (int bj = 0; bj < 2; ++bj) {
                    f32x4 v0 = acc[ai][bj][m][0], v1 = acc[ai][bj][m][1];
                    if (rope_on) {
                        f32x4 o0, o1;
#pragma unroll
                        for (int i = 0; i < 4; ++i) { o0[i] = __shfl_xor(v0[i], 16); o1[i] = __shfl_xor(v1[i], 16); }
                        const float sg = (fq == 0) ? -1.f : 1.f;
                        if (fq < 2) { v0 = v0 * c0 + (o0 * s0) * sg; v1 = v1 * c1 + (o1 * s1) * sg; }
                    }
                    v0 = v0 * sc; v1 = v1 * sc;
                    u32x4 w; w.x = cvt_pk_bf16(v0[0], v0[1]); w.y = cvt_pk_bf16(v0[2], v0[3]); w.z = cvt_pk_bf16(v1[0], v1[1]); w.w = cvt_pk_bf16(v1[2], v1[3]);
                    *(u32x4*)(rowp + bj * HALF) = w;
                }
            }
    }
};
struct EpiGateA {
    static constexpr bool PERM = true, AFTER_DRAIN = false;
    float* T; const bf16_t* ga;
    __device__ __forceinline__ void operator()(const f32x4 (&acc)[2][2][4][2], const Unit& u, int wr, int wc, int fr, int fq) const {
        const int row0 = u.pm * BM + wr * 64 + fr, col0 = u.pn * BM + wc * 32 + 8 * fq;
#pragma unroll
        for (int ai = 0; ai < 2; ++ai)
#pragma unroll
            for (int m = 0; m < 4; ++m)
#pragma unroll
                for (int bj = 0; bj < 2; ++bj) {
                    const size_t off = (size_t)(row0 + ai * HALF + m * 16) * D + col0 + bj * HALF;
                    const u32x4 g = *(const u32x4*)(ga + off);
                    f32x4 v0 = acc[ai][bj][m][0], v1 = acc[ai][bj][m][1];
                    v0[0] *= fast_sigmoid(__uint_as_float(g.x << 16)); v0[1] *= fast_sigmoid(__uint_as_float(g.x & 0xffff0000u));
                    v0[2] *= fast_sigmoid(__uint_as_float(g.y << 16)); v0[3] *= fast_sigmoid(__uint_as_float(g.y & 0xffff0000u));
                    v1[0] *= fast_sigmoid(__uint_as_float(g.z << 16)); v1[1] *= fast_sigmoid(__uint_as_float(g.z & 0xffff0000u));
                    v1[2] *= fast_sigmoid(__uint_as_float(g.w << 16)); v1[3] *= fast_sigmoid(__uint_as_float(g.w & 0xffff0000u));
                    *(f32x4*)(T + off) = v0; *(f32x4*)(T + off + 4) = v1;
                }
    }
};
struct EpiGateB {
    static constexpr bool PERM = true, AFTER_DRAIN = false;
    const float* T; const bf16_t* gb; bf16_t* O;
    __device__ __forceinline__ void operator()(const f32x4 (&acc)[2][2][4][2], const Unit& u, int wr, int wc, int fr, int fq) const {
        const int row0 = u.pm * BM + wr * 64 + fr, col0 = u.pn * BM + wc * 32 + 8 * fq;
#pragma unroll
        for (int ai = 0; ai < 2; ++ai)
#pragma unroll
            for (int m = 0; m < 4; ++m)
#pragma unroll
                for (int bj = 0; bj < 2; ++bj) {
                    const size_t off = (size_t)(row0 + ai * HALF + m * 16) * D + col0 + bj * HALF;
                    const u32x4 g = *(const u32x4*)(gb + off);
                    const f32x4 t0 = *(const f32x4*)(T + off), t1 = *(const f32x4*)(T + off + 4);
                    f32x4 v0 = acc[ai][bj][m][0], v1 = acc[ai][bj][m][1];
                    v0[0] = t0[0] + v0[0] * fast_sigmoid(__uint_as_float(g.x << 16)); v0[1] = t0[1] + v0[1] * fast_sigmoid(__uint_as_float(g.x & 0xffff0000u));
                    v0[2] = t0[2] + v0[2] * fast_sigmoid(__uint_as_float(g.y << 16)); v0[3] = t0[3] + v0[3] * fast_sigmoid(__uint_as_float(g.y & 0xffff0000u));
                    v1[0] = t1[0] + v1[0] * fast_sigmoid(__uint_as_float(g.z << 16)); v1[1] = t1[1] + v1[1] * fast_sigmoid(__uint_as_float(g.z & 0xffff0000u));
                    v1[2] = t1[2] + v1[2] * fast_sigmoid(__uint_as_float(g.w << 16)); v1[3] = t1[3] + v1[3] * fast_sigmoid(__uint_as_float(g.w & 0xffff0000u));
                    u32x4 w; w.x = cvt_pk_bf16(v0[0], v0[1]); w.y = cvt_pk_bf16(v0[2], v0[3]); w.z = cvt_pk_bf16(v1[0], v1[1]); w.w = cvt_pk_bf16(v1[2], v1[3]);
                    *(u32x4*)(O + off) = w;
                }
    }
};
struct EpiResid {
    static constexpr bool PERM = false, AFTER_DRAIN = false;
    const float* base; float* out; const float* gate;
    __device__ __forceinline__ void operator()(const f32x4 (&acc)[2][2][4][2], const Unit& u, int wr, int wc, int fr, int fq) const {
        const int row0 = u.pm * BM + wr * 64 + fr, col0 = u.pn * BM + wc * 32 + 4 * fq;
        const float* gp = gate + (size_t)(u.pm / (SEQ / BM)) * 6144;
#pragma unroll
        for (int bj = 0; bj < 2; ++bj)
#pragma unroll
            for (int n = 0; n < 2; ++n) {
                const int col = col0 + bj * HALF + n * 16; const f32x4 gv = *(const f32x4*)(gp + col);
#pragma unroll
                for (int ai = 0; ai < 2; ++ai)
#pragma unroll
                    for (int m = 0; m < 4; ++m) { const size_t off = (size_t)(row0 + ai * HALF + m * 16) * D + col;
                        const f32x4 bs = *(const f32x4*)(base + off); *(f32x4*)(out + off) = bs + gv * acc[ai][bj][m][n]; }
            }
    }
};
struct EpiSwiglu {
    static constexpr bool PERM = true, AFTER_DRAIN = false;
    bf16_t* O;
    __device__ __forceinline__ void operator()(const f32x4 (&acc)[2][2][4][2], const Unit& u, int wr, int wc, int fr, int fq) const {
        const int row0 = u.pm * BM + wr * 64 + fr, col0 = u.pn * HALF + wc * 32 + 8 * fq;
#pragma unroll
        for (int ai = 0; ai < 2; ++ai)
#pragma unroll
            for (int m = 0; m < 4; ++m) {
                f32x4 a0 = acc[ai][0][m][0], a1 = acc[ai][0][m][1]; const f32x4 u0 = acc[ai][1][m][0], u1 = acc[ai][1][m][1];
#pragma unroll
                for (int i = 0; i < 4; ++i) { a0[i] = a0[i] * fast_sigmoid(a0[i]) * u0[i]; a1[i] = a1[i] * fast_sigmoid(a1[i]) * u1[i]; }
                u32x4 w; w.x = cvt_pk_bf16(a0[0], a0[1]); w.y = cvt_pk_bf16(a0[2], a0[3]); w.z = cvt_pk_bf16(a1[0], a1[1]); w.w = cvt_pk_bf16(a1[2], a1[3]);
                *(u32x4*)(O + (size_t)(row0 + ai * HALF + m * 16) * D_FF + col0) = w;
            }
    }
};
}

__device__ __forceinline__ void tr_item(const float* W, int ldw, int k0, int n0s, bf16* WT, int K, int drow0, LAS float* scr, int lane) {
#pragma unroll 8
    for (int i = 0; i < 32; ++i) { const int kk = 2 * i + (lane >> 5); scr[kk * 33 + (lane & 31)] = W[(size_t)(k0 + kk) * ldw + n0s + (lane & 31)]; }
    LDS_WAIT(); asm volatile("" ::: "memory");
    const int c = lane & 7;
#pragma unroll
    for (int j = 0; j < 4; ++j) { const int n = (lane >> 3) + 8 * j; const LAS float* s = scr + (8 * c) * 33 + n;
        v4u o; o.x = pk2(s[0 * 33], s[1 * 33]); o.y = pk2(s[2 * 33], s[3 * 33]); o.z = pk2(s[4 * 33], s[5 * 33]); o.w = pk2(s[6 * 33], s[7 * 33]);
        *(GAS v4u*)(WT + (size_t)(drow0 + n) * K + k0 + 8 * c) = o; }
    LDS_WAIT(); asm volatile("" ::: "memory");
}
struct Ptrs {
    const float *x, *c, *w_ada, *b_ada, *g_mix, *w_in, *b_fgate, *w_br_a, *w_br_b, *w_out, *g_ffn, *w_gate, *w_up, *w_down, *g_final;
    float* out; unsigned char* ws;
};
__device__ __forceinline__ void p0_prologue(Frame& F, const Ptrs& P) {
    unsigned char* ws = P.ws;
    { LAS float* red = (LAS float*)(F.lds + RING_OFF); float* mod = (float*)(ws + WS_MOD);
      for (int ch = F.vcu; ch < 256; ch += F.G) {
          const int col = F.tid % 24, sl = F.tid / 24;
          if (F.tid < 504) { float acc[8];
#pragma unroll
              for (int b = 0; b < 8; ++b) acc[b] = 0.f;
              for (int d = sl; d < D; d += 21) { const float wv = P.w_ada[(size_t)d * 6144 + ch * 24 + col];
#pragma unroll
                  for (int b = 0; b < 8; ++b) { const float cv = P.c[b * D + d]; acc[b] += cv * fast_sigmoid(cv) * wv; } }
#pragma unroll
              for (int b = 0; b < 8; ++b) red[(sl * 8 + b) * 24 + col] = acc[b]; }
          __syncthreads();
          if (F.tid < 192) { const int b = F.tid / 24, c2 = F.tid % 24; float s = 0.f;
              for (int q = 0; q < 21; ++q) s += red[(q * 8 + b) * 24 + c2];
              mod[b * 6144 + ch * 24 + c2] = s + P.b_ada[ch * 24 + c2]; }
          __syncthreads();
      } }
    { const int i = F.vcu * (NWAVES * 64) + F.tid;
      if (i < SEQ * 8) { const int pos = i >> 3, j = i & 7;
          float inv_freq = 1.0f;
          inv_freq = (j == 1) ? 0.19392274474868576f : inv_freq; inv_freq = (j == 2) ? 0.03760603093086393f : inv_freq; inv_freq = (j == 3) ? 0.007292664737217109f : inv_freq;
          inv_freq = (j == 4) ? 0.001414213562373095f : inv_freq; inv_freq = (j == 5) ? 0.0002742481756762073f : inv_freq; inv_freq = (j == 6) ? 5.318295896944988e-05f : inv_freq;
          inv_freq = (j == 7) ? 1.031338537721246e-05f : inv_freq;
          const float ang = (float)pos * inv_freq; const double a = (double)ang; const double k = rint(a * 0.15915494309189535); const float r = (float)(a - k * 6.283185307179586);
          float* tab = (float*)(ws + WS_ROPE); tab[i * 2] = __cosf(r); tab[i * 2 + 1] = __sinf(r); } }
    LAS float* scr = (LAS float*)(F.lds + RING_OFF + F.wave * 16384);
    const int gw = F.vcu * NWAVES + F.wave, NGW = F.G * NWAVES;
    constexpr int I_IN = 16 * 184, I_A = 8 * 32, I_B = 4 * 32, I_O = 16 * 32, I_G = 16 * 88, I_D = 44 * 32;
    constexpr int NITEMS = I_IN + I_A + I_B + I_O + 2 * I_G + I_D;
    for (int it = gw; it < NITEMS; it += NGW) {
        int r = it;
        if (r < I_IN) { const int kb = r / 184, nb = r % 184, n0 = 32 * nb; tr_item(P.w_in, IN_COLS, 64 * kb, n0 < C_FA ? n0 : n0 + 8, (bf16*)(ws + WS_WIN), D, n0, scr, F.lane); continue; } r -= I_IN;
        if (r < I_A) { const int kb = r / 32, nb = r % 32; tr_item(P.w_br_a, D, 64 * kb, 32 * nb, (bf16*)(ws + WS_WBRA), FOX_W, 32 * nb, scr, F.lane); continue; } r -= I_A;
        if (r < I_B) { const int kb = r / 32, nb = r % 32; tr_item(P.w_br_b, D, 64 * kb, 32 * nb, (bf16*)(ws + WS_WBRB), DIL_OUT_W, 32 * nb, scr, F.lane); continue; } r -= I_B;
        if (r < I_O) { const int kb = r / 32, nb = r % 32; tr_item(P.w_out, D, 64 * kb, 32 * nb, (bf16*)(ws + WS_WOUT), D, 32 * nb, scr, F.lane); continue; } r -= I_O;
        if (r < 2 * I_G) { const int up = r >= I_G ? 1 : 0; r -= up * I_G; const int kb = r / 88, nb = r % 88, n0 = 32 * nb;
            tr_item(up ? P.w_up : P.w_gate, D_FF, 64 * kb, n0, (bf16*)(ws + WS_WGU), D, 256 * (n0 >> 7) + (n0 & 127) + 128 * up, scr, F.lane); continue; } r -= 2 * I_G;
        { const int kb = r / 32, nb = r % 32; tr_item(P.w_down, D, 64 * kb, 32 * nb, (bf16*)(ws + WS_WDN), D_FF, 32 * nb, scr, F.lane); }
    }
}
template <bool WITH_FA>
__device__ __forceinline__ void norm_mod_rows(Frame& F, const float* x, const float* g, const float* mod, int sh_off, int sc_off, bf16* outp, const LAS float* wfa, const float* b_fgate, float* lf) {
    const int gw = F.vcu * NWAVES + F.wave, NGW = F.G * NWAVES;
    for (int m = gw; m < M; m += NGW) {
        const int b = m / SEQ;
        const GAS f32x4* xr = (const GAS f32x4*)(x + (size_t)m * D) + F.lane;
        f32x4 v[4]; float s2 = 0.f;
#pragma unroll
        for (int j = 0; j < 4; ++j) { v[j] = xr[64 * j]; s2 += (v[j].x * v[j].x + v[j].y * v[j].y) + (v[j].z * v[j].z + v[j].w * v[j].w); }
        const float rstd = 1.f / sqrtf(wave_sum(s2) * (1.f / D) + EPS);
        const f32x4* gp = (const f32x4*)g + F.lane; const f32x4* scp = (const f32x4*)(mod + b * 6144 + sc_off) + F.lane; const f32x4* shp = (const f32x4*)(mod + b * 6144 + sh_off) + F.lane;
        GAS unsigned long long* o8 = (GAS unsigned long long*)(outp + (size_t)m * D) + F.lane;
        float fa[8];
#pragma unroll
        for (int h = 0; h < 8; ++h) fa[h] = 0.f;
#pragma unroll
        for (int j = 0; j < 4; ++j) {
            const f32x4 gv = gp[64 * j], sc = scp[64 * j], sh = shp[64 * j];
            const f32x4 hv = (v[j] * rstd) * gv * (sc + 1.0f) + sh;
            o8[64 * j] = (unsigned long long)pk2(hv.x, hv.y) | ((unsigned long long)pk2(hv.z, hv.w) << 32);
            if (WITH_FA) {
#pragma unroll
                for (int h = 0; h < 8; ++h) { const f32x4 w = *(const LAS f32x4*)(wfa + h * D + 4 * F.lane + 256 * j); fa[h] += (hv.x * w.x + hv.y * w.y) + (hv.z * w.z + hv.w * w.w); }
            }
        }
        if (WITH_FA) {
#pragma unroll
            for (int h = 0; h < 8; ++h) { const float s = wave_sum(fa[h]) + b_fgate[h]; const float ls = fminf(s, 0.f) - log1pf(__expf(-fabsf(s))); if (F.lane == 0) lf[(size_t)m * 8 + h] = ls; }
        }
    }
}
__device__ __forceinline__ void final_rows(Frame& F, float* x, const float* g) {
    const int gw = F.vcu * NWAVES + F.wave, NGW = F.G * NWAVES;
    for (int m = gw; m < M; m += NGW) {
        GAS f32x4* xr = (GAS f32x4*)(x + (size_t)m * D) + F.lane;
        f32x4 v[4]; float s2 = 0.f;
#pragma unroll
        for (int j = 0; j < 4; ++j) { v[j] = xr[64 * j]; s2 += (v[j].x * v[j].x + v[j].y * v[j].y) + (v[j].z * v[j].z + v[j].w * v[j].w); }
        const float rstd = 1.f / sqrtf(wave_sum(s2) * (1.f / D) + EPS);
        const f32x4* gp = (const f32x4*)g + F.lane;
#pragma unroll
        for (int j = 0; j < 4; ++j) xr[64 * j] = (v[j] * rstd) * gp[64 * j];
    }
}
__device__ __forceinline__ void cumsum_phase(Frame& F, const float* lf, float* fc) {
    for (int bh = blockIdx.x; bh < 64; bh += F.G) {
        const int b = bh >> 3, h = bh & 7, t0 = F.tid * 4;
        float p[4];
#pragma unroll
        for (int i = 0; i < 4; ++i) p[i] = lf[((size_t)(b * SEQ + t0 + i)) * 8 + h];
        p[1] += p[0]; p[2] += p[1]; p[3] += p[2];
        float inc = p[3];
#pragma unroll
        for (int o = 1; o < 64; o <<= 1) { const float n = __shfl_up(inc, o); if (F.lane >= o) inc += n; }
        LAS float* wt = (LAS float*)(F.lds + RING_OFF);
        if (F.lane == 63) wt[F.wave] = inc;
        __syncthreads();
        float off = inc - p[3];
        for (int w = 0; w < F.wave; ++w) off += wt[w];
        *(f32x4*)(fc + (size_t)bh * SEQ + t0) = (f32x4){p[0] + off, p[1] + off, p[2] + off, p[3] + off};
        __syncthreads();
    }
}
__device__ __forceinline__ void dil_combine(Frame& F, const bf16* OG, const float* LSE, bf16* yb) {
    const int gw = F.vcu * NWAVES + F.wave, NGW = F.G * NWAVES, hs = F.lane >> 4;
    for (int m = gw; m < M; m += NGW) {
        float l0 = LSE[((size_t)0 * M + m) * 4 + hs], l1 = LSE[((size_t)1 * M + m) * 4 + hs], l2 = LSE[((size_t)2 * M + m) * 4 + hs];
        const float mx = fmaxf(l0, fmaxf(l1, l2));
        float w0 = __builtin_amdgcn_exp2f(l0 - mx), w1 = __builtin_amdgcn_exp2f(l1 - mx), w2 = __builtin_amdgcn_exp2f(l2 - mx);
        const float inv = 1.0f / (w0 + w1 + w2); w0 *= inv; w1 *= inv; w2 *= inv;
        const unsigned long long a = *((const GAS unsigned long long*)(OG + ((size_t)0 * M + m) * DIL_OUT_W) + F.lane);
        const unsigned long long b = *((const GAS unsigned long long*)(OG + ((size_t)1 * M + m) * DIL_OUT_W) + F.lane);
        const unsigned long long c = *((const GAS unsigned long long*)(OG + ((size_t)2 * M + m) * DIL_OUT_W) + F.lane);
        float y[4];
#pragma unroll
        for (int i = 0; i < 4; ++i) y[i] = w0 * bf2f((unsigned short)(a >> (16 * i))) + w1 * bf2f((unsigned short)(b >> (16 * i))) + w2 * bf2f((unsigned short)(c >> (16 * i)));
        *((GAS unsigned long long*)(yb + (size_t)m * DIL_OUT_W) + F.lane) = (unsigned long long)pk2(y[0], y[1]) | ((unsigned long long)pk2(y[2], y[3]) << 32);
    }
}

__global__ void __launch_bounds__(NWAVES * 64, 2) mega_fwd(Ptrs P) {
    extern __shared__ __attribute__((aligned(16))) unsigned char lds[];
    Frame F;
    F.lds = (LAS unsigned char*)lds;
    F.MISC = (volatile LAS unsigned*)(F.lds + MISC_OFF);
#define FRESH_TID() do { int t_ = threadIdx.x; asm volatile("" : "+v"(t_)); F.tid = t_; F.lane = t_ & 63; F.wave = __builtin_amdgcn_readfirstlane(t_ >> 6); } while (0)
    FRESH_TID();
    F.G = gridDim.x; { const int bx = blockIdx.x; F.vcu = (F.G % 8 == 0) ? (bx % 8) * (F.G / 8) + bx / 8 : bx; }
    unsigned char* ws = P.ws;
    F.ctl = (gu32*)(ws + WS_CTL);
    for (int u = F.tid; u < (LDS_BYTES - LDSCTL_OFF) / 4; u += NWAVES * 64) ((LAS unsigned*)(F.lds + LDSCTL_OFF))[u] = 0u;
    __syncthreads();
    XcdBarrier bar = xcd_barrier_post((unsigned*)(F.ctl + CW_BAR), F.MISC + 8);
#define GRID_BAR() xcd_barrier(bar)
    float* mod = (float*)(ws + WS_MOD); float* rope = (float*)(ws + WS_ROPE); float* lf = (float*)(ws + WS_LF); float* fc = (float*)(ws + WS_FC);
    bf16* XN = (bf16*)(ws + WS_XN); bf16* YA = (bf16*)(ws + WS_YA); bf16* YB = (bf16*)(ws + WS_YB); bf16* H2 = (bf16*)(ws + WS_H2);
    bf16* FOX = (bf16*)(ws + WS_FOX); bf16* DIL = (bf16*)(ws + WS_DIL); bf16* GATE = (bf16*)(ws + WS_GATE); bf16* MERGED = (bf16*)(ws + WS_MERGED); bf16* ACT = (bf16*)(ws + WS_ACT);
    bf16* OG = (bf16*)P.out; float* LSE = (float*)((unsigned char*)P.out + 24 * MiB);

    FRESH_TID(); p0_prologue(F, P);
    GRID_BAR();
    FRESH_TID();
    { LAS float* wfa = (LAS float*)(F.lds + RING_OFF);
      for (int i = F.tid; i < 8 * D; i += NWAVES * 64) { const int h = i >> 10, d = i & (D - 1); wfa[i] = P.w_in[(size_t)d * IN_COLS + C_FA + h]; }
      __syncthreads();
      norm_mod_rows<true>(F, P.x, P.g_mix, mod, MOD_SH_M, MOD_SC_M, XN, wfa, P.b_fgate, lf);
      __syncthreads(); }
    GRID_BAR();
    FRESH_TID(); cumsum_phase(F, lf, fc);
    { pg8::Gemm g{XN, (const bf16*)(ws + WS_WIN), M, N_IN, D}; pg8::StaticOrder S; S.init(M, N_IN, F.G, (int)blockIdx.x);
      pg8::EpiInProj E{FOX, DIL, GATE, rope};
      pg8::gemm_phase<pg8::EpiInProj, pg8::StaticOrder, PG8_ALIGN, PG8_SP2>(F.lds + RING_OFF, g, S, E); }
    GRID_BAR();
    { const attn_body::DilTensors DT{(const attn_body::bf16*)DIL, (const attn_body::bf16*)(DIL + (size_t)M * DIL_W), (const attn_body::bf16*)(DIL + (size_t)2 * M * DIL_W), (attn_body::bf16*)OG, LSE};
      for (int uu = F.vcu; uu < 768; uu += F.G) { const int w = uu & 255, gi = uu >> 8; attn_body::dil_unit((w >> 3) * 24 + gi * 8 + (w & 7), DT, (char*)lds + RING_OFF); } }
    GRID_BAR();
    { const attn_body::AttnTensors AT{(const attn_body::bf16*)FOX, (const attn_body::bf16*)(FOX + (size_t)M * FOX_W), (const attn_body::bf16*)(FOX + (size_t)2 * M * FOX_W), (attn_body::bf16*)YA, fc};
      const attn_body::StaticOrder S((int)F.G, (int)blockIdx.x);
      attn_body::attn_phase<attn_body::StaticOrder>((char*)lds + RING_OFF, AT, S); }
    FRESH_TID(); dil_combine(F, OG, LSE, YB);
    GRID_BAR();
    { pg8::Gemm g{YA, (const bf16*)(ws + WS_WBRA), M, D, FOX_W}; pg8::StaticOrder S; S.init(M, D, F.G, (int)blockIdx.x);
      pg8::EpiGateA E{P.out, GATE};
      pg8::gemm_phase<pg8::EpiGateA, pg8::StaticOrder, false, PG8_SP2>(F.lds + RING_OFF, g, S, E); }
    { pg8::Gemm g{YB, (const bf16*)(ws + WS_WBRB), M, D, DIL_OUT_W}; pg8::StaticOrder S; S.init(M, D, F.G, (int)blockIdx.x);
      pg8::EpiGateB E{P.out, GATE + (size_t)M * D, MERGED};
      pg8::gemm_phase<pg8::EpiGateB, pg8::StaticOrder, false, PG8_SP2>(F.lds + RING_OFF, g, S, E); }
    GRID_BAR();
    { pg8::Gemm g{MERGED, (const bf16*)(ws + WS_WOUT), M, D, D}; pg8::StaticOrder S; S.init(M, D, F.G, (int)blockIdx.x);
      pg8::EpiResid E{P.x, P.out, mod + MOD_GA_M};
      pg8::gemm_phase<pg8::EpiResid, pg8::StaticOrder, false, PG8_SP2>(F.lds + RING_OFF, g, S, E); }
    GRID_BAR();
    FRESH_TID(); norm_mod_rows<false>(F, P.out, P.g_ffn, mod, MOD_SH_F, MOD_SC_F, H2, nullptr, nullptr, nullptr);
    GRID_BAR();
    { pg8::Gemm g{H2, (const bf16*)(ws + WS_WGU), M, N_GU, D}; pg8::StaticOrder S; S.init(M, N_GU, F.G, (int)blockIdx.x);
      pg8::EpiSwiglu E{ACT};
      pg8::gemm_phase<pg8::EpiSwiglu, pg8::StaticOrder, PG8_ALIGN, PG8_SP2>(F.lds + RING_OFF, g, S, E); }
    GRID_BAR();
    { pg8::Gemm g{ACT, (const bf16*)(ws + WS_WDN), M, D, D_FF}; pg8::StaticOrder S; S.init(M, D, F.G, (int)blockIdx.x);
      pg8::EpiResid E{P.out, P.out, mod + MOD_GA_F};
      pg8::gemm_phase<pg8::EpiResid, pg8::StaticOrder, false, PG8_SP2>(F.lds + RING_OFF, g, S, E); }
    GRID_BAR();
    FRESH_TID(); final_rows(F, P.out, P.g_final);
}

extern "C" void kernel_launch(void* const* d_in, const int* in_sizes, int n_in, void* d_out, int out_size, void* d_ws, size_t ws_size, hipStream_t stream) {
    static int grid = 0;
    if (grid == 0) {
        if (n_in != 15 || in_sizes[0] != M * D || out_size != M * D || ws_size < WS_END) { fprintf(stderr, "kernel_launch: unexpected shapes: n_in %d in0 %d out %d ws %zu\n", n_in, n_in > 0 ? in_sizes[0] : -1, out_size, ws_size); grid = -1; return; }
        int dev = 0, cus = 0, per_cu = 0;
        if (hipGetDevice(&dev) != hipSuccess || hipDeviceGetAttribute(&cus, hipDeviceAttributeMultiprocessorCount, dev) != hipSuccess) { grid = -1; return; }
        if (hipFuncSetAttribute((const void*)mega_fwd, hipFuncAttributeMaxDynamicSharedMemorySize, LDS_BYTES) != hipSuccess) { fprintf(stderr, "kernel_launch: hipFuncSetAttribute failed\n"); grid = -1; return; }
        if (hipOccupancyMaxActiveBlocksPerMultiprocessor(&per_cu, (const void*)mega_fwd, NWAVES * 64, LDS_BYTES) != hipSuccess || per_cu < 1) { fprintf(stderr, "kernel_launch: occupancy query says %d blocks per CU\n", per_cu); per_cu = 1; }
        (void)hipGetLastError();
        grid = cus;
        if (grid != 256) fprintf(stderr, "kernel_launch: %d CUs; this build assumes 256\n", grid);
    }
    if (grid < 0) return;
    (void)hipMemsetAsync((char*)d_ws + WS_CTL, 0, CTL_ZERO_BYTES, stream);
    Ptrs p{};
    p.x = (const float*)d_in[0]; p.c = (const float*)d_in[1]; p.w_ada = (const float*)d_in[2]; p.b_ada = (const float*)d_in[3]; p.g_mix = (const float*)d_in[4];
    p.w_in = (const float*)d_in[5]; p.b_fgate = (const float*)d_in[6]; p.w_br_a = (const float*)d_in[7]; p.w_br_b = (const float*)d_in[8]; p.w_out = (const float*)d_in[9];
    p.g_ffn = (const float*)d_in[10]; p.w_gate = (const float*)d_in[11]; p.w_up = (const float*)d_in[12]; p.w_down = (const float*)d_in[13]; p.g_final = (const float*)d_in[14];
    p.out = (float*)d_out; p.ws = (unsigned char*)d_ws;
    hipLaunchKernelGGL(mega_fwd, dim3(grid), dim3(NWAVES * 64), LDS_BYTES, stream, p);
}
```
